# Optimizing an MI355X kernel written in HIP

```python
import jax, jax.numpy as jnp
from jax import lax
import numpy as np

D_MODEL = 1024
BATCH = 4
SEQ = 8192
DEPTH = 1
DEC_BATCH = 32
DEC_SEQ = 32
PAST_LEN = 2048

CHUNK = 64
N_HEADS_A = 16
N_KV_A = 2
HEAD_DIM_A = 64
GROUP_A = N_HEADS_A // N_KV_A
WINDOW = 128
WINDOW_CHUNKS = WINDOW // CHUNK
KV_WIN = min(WINDOW, PAST_LEN)
N_HEADS_B = 4
DQK_B = 128
DV_B = 256
D_FF = 2816
CONV_W = 3
LN_EPS = 1e-5
ALPHA = (2 * DEPTH) ** 0.25
BETA = (8 * DEPTH) ** -0.25
Q_A = N_HEADS_A * HEAD_DIM_A
KV_A_W = N_KV_A * HEAD_DIM_A
QK_B = N_HEADS_B * DQK_B
V_B = N_HEADS_B * DV_B
Z_PARTS = (Q_A, KV_A_W, KV_A_W, QK_B, QK_B, V_B, N_HEADS_B, N_HEADS_B, V_B, D_MODEL, D_MODEL)
Z_WIDTH = int(sum(Z_PARTS))
Z_OFFSETS = tuple(int(v) for v in np.cumsum(Z_PARTS)[:-1])

kernel_name = 'streaming_swa_mlstm_convffn_hybrid_step'


def layer_norm(x, w, b):
    xf = x.astype(jnp.float32)
    mu = jnp.mean(xf, -1, keepdims=True)
    var = jnp.mean(jnp.square(xf - mu), -1, keepdims=True)
    y = (xf - mu) * lax.rsqrt(var + LN_EPS)
    return (y * w.astype(jnp.float32) + b.astype(jnp.float32)).astype(x.dtype)


def head_norm(h, w):
    N, T = h.shape[:2]
    hf = h.astype(jnp.float32)
    mu = jnp.mean(hf, -1, keepdims=True)
    var = jnp.mean(jnp.square(hf - mu), -1, keepdims=True)
    y = ((hf - mu) * lax.rsqrt(var + LN_EPS)).reshape(N, T, V_B)
    return (y * w.astype(jnp.float32)).astype(h.dtype)


def alibi_slopes():
    return 2.0 ** (-8.0 * jnp.arange(1, N_HEADS_A + 1, dtype=jnp.float32) / N_HEADS_A)


def banded_attention(qb, kb, vb, qpos, kpos, sinks):
    s = jnp.einsum('nbqhgd,nbshd->nbhgqs', qb.astype(jnp.float32), kb.astype(jnp.float32)) * (HEAD_DIM_A ** -0.5)
    qc = qpos // CHUNK
    kc = kpos // CHUNK
    visible = ((kpos[:, None, :] >= 0) & (kc[:, None, :] <= qc[:, :, None])
               & (kc[:, None, :] >= qc[:, :, None] - WINDOW_CHUNKS))
    dist = jnp.abs(qpos[:, :, None] - kpos[:, None, :]).astype(jnp.float32)
    slopes = alibi_slopes().reshape(N_KV_A, GROUP_A)
    s = s - slopes[None, None, :, :, None, None] * dist[None, :, None, None]
    s = jnp.where(visible[None, :, None, None], s, -jnp.inf)
    sink = sinks.astype(jnp.float32).reshape(1, 1, N_KV_A, GROUP_A, 1, 1)
    mx = jnp.maximum(jnp.max(s, -1, keepdims=True), sink)
    p = jnp.exp(s - mx)
    p = p / (jnp.sum(p, -1, keepdims=True) + jnp.exp(sink - mx))
    o = jnp.einsum('nbhgqs,nbshd->nbqhgd', p, vb.astype(jnp.float32))
    return o.astype(qb.dtype)


def local_attention(q, k, v, k_cache, v_cache, sinks):
    N, T = q.shape[:2]
    if k_cache is None:
        nb = T // CHUNK
        pad = WINDOW_CHUNKS * CHUNK
        span = (WINDOW_CHUNKS + 1) * CHUNK
        qb = q.reshape(N, nb, CHUNK, N_KV_A, GROUP_A, HEAD_DIM_A)

        def bands(a):
            ap = jnp.pad(a, ((0, 0), (pad, 0), (0, 0), (0, 0)))
            ap = ap.reshape(N, nb + WINDOW_CHUNKS, CHUNK, N_KV_A, HEAD_DIM_A)
            return jnp.concatenate([ap[:, j:j + nb] for j in range(WINDOW_CHUNKS + 1)], axis=2)

        kb, vb = bands(k), bands(v)
        qpos = jnp.arange(T).reshape(nb, CHUNK)
        kpos = jnp.arange(nb)[:, None] * CHUNK - pad + jnp.arange(span)[None, :]
        k_win, v_win = k[:, T - KV_WIN:], v[:, T - KV_WIN:]
    else:
        kk = jnp.concatenate([k_cache.astype(k.dtype), k], axis=1)
        vv = jnp.concatenate([v_cache.astype(v.dtype), v], axis=1)
        qb = q.reshape(N, 1, T, N_KV_A, GROUP_A, HEAD_DIM_A)
        kb, vb = kk[:, None], vv[:, None]
        qpos = (PAST_LEN + jnp.arange(T))[None]
        kpos = (PAST_LEN - KV_WIN + jnp.arange(KV_WIN + T))[None]
        k_win, v_win = kk[:, T:], vv[:, T:]
    o = banded_attention(qb, kb, vb, qpos, kpos, sinks)
    return o.reshape(N, T, Q_A), k_win, v_win


def mlstm_chunkwise(q, k, v, i_pre, logf, C0, n0, m0, chunk):
    N, T = q.shape[:2]
    nc = T // chunk

    def to_chunks(a):
        a = a.astype(jnp.float32).reshape((N, nc, chunk) + a.shape[2:])
        return jnp.swapaxes(jnp.moveaxis(a, 1, 0), 2, 3)

    xs = (to_chunks(q), to_chunks(k), to_chunks(v), to_chunks(i_pre), to_chunks(logf))
    causal = jnp.tril(jnp.ones((chunk, chunk), dtype=bool))

    def step(carry, inp):
        C, n, m = carry
        qc, kc, vc, ic, fc = inp
        b = jnp.cumsum(fc, axis=-1)
        dmat = jnp.where(causal, b[..., :, None] - b[..., None, :] + ic[..., None, :], -jnp.inf)
        inter = b + m[..., None]
        m_t = jnp.maximum(jnp.max(dmat, -1), inter)
        w = jnp.exp(dmat - m_t[..., None])
        g = jnp.exp(inter - m_t)
        s = jnp.einsum('nhld,nhsd->nhls', qc, kc) * w
        num = jnp.einsum('nhls,nhsv->nhlv', s, vc) + g[..., None] * jnp.einsum('nhvd,nhld->nhlv', C, qc)
        den = jnp.sum(s, -1) + g * jnp.einsum('nhd,nhld->nhl', n, qc)
        h = num / jnp.maximum(jnp.abs(den), jnp.exp(-m_t))[..., None]
        m_new = m_t[..., -1]
        wk = jnp.exp(b[..., -1:] - b + ic - m_new[..., None])
        decay = jnp.exp(b[..., -1] + m - m_new)
        C_new = decay[..., None, None] * C + jnp.einsum('nhl,nhlv,nhld->nhvd', wk, vc, kc)
        n_new = decay[..., None] * n + jnp.einsum('nhl,nhld->nhd', wk, kc)
        return (C_new, n_new, m_new), h

    init = (C0.astype(jnp.float32), n0.astype(jnp.float32), m0.astype(jnp.float32))
    (C, n, m), h = lax.scan(step, init, xs)
    h = jnp.moveaxis(jnp.swapaxes(h, 2, 3), 0, 1).reshape(N, T, N_HEADS_B, DV_B)
    return h.astype(q.dtype), C, n, m


def conv_ffn(h, conv_buf, w_up, b_up, conv_w, conv_b, w_down):
    T = h.shape[1]
    u = h @ w_up + b_up
    ctx = jnp.concatenate([conv_buf.astype(u.dtype), u], axis=1)
    uc = conv_b + sum(conv_w[j] * ctx[:, j:j + T] for j in range(CONV_W))
    a, g = jnp.split(uc, 2, axis=-1)
    return (a * jax.nn.gelu(g)) @ w_down, ctx[:, T:]


def trunk_layer(x, c, k_cache, v_cache, C0, n0, m0, conv_buf, mlstm_chunk, prm):
    N, T, _ = x.shape
    mod = jax.nn.silu(c) @ prm['w_ada'] + prm['b_ada']
    sh1, sc1, g1, sh2, sc2, g2 = jnp.split(mod[:, None, :], 6, axis=-1)
    h = x * (1 + sc1) + sh1
    z = h @ prm['w_in']
    qa, ka, va, qm, km, vm, ig, fg, og, ga, gb = jnp.split(z, Z_OFFSETS, axis=-1)
    ya, k_win, v_win = local_attention(qa.reshape(N, T, N_HEADS_A, HEAD_DIM_A),
                                       ka.reshape(N, T, N_KV_A, HEAD_DIM_A),
                                       va.reshape(N, T, N_KV_A, HEAD_DIM_A),
                                       k_cache, v_cache, prm['attn_sinks'])
    i_pre = (ig + prm['b_igate']).astype(jnp.float32)
    logf = jax.nn.log_sigmoid((fg + prm['b_fgate']).astype(jnp.float32))
    hm, C, n, m = mlstm_chunkwise(qm.reshape(N, T, N_HEADS_B, DQK_B),
                                  km.reshape(N, T, N_HEADS_B, DQK_B) * (DQK_B ** -0.5),
                                  vm.reshape(N, T, N_HEADS_B, DV_B),
                                  i_pre, logf, C0, n0, m0, mlstm_chunk)
    yb = jax.nn.sigmoid(og) * head_norm(hm, prm['mlstm_norm_w'])
    merged = jax.nn.sigmoid(ga) * (ya @ prm['w_proj_a']) + jax.nn.sigmoid(gb) * (yb @ prm['w_proj_b'])
    x = layer_norm(ALPHA * x + g1 * (merged @ prm['w_out']), prm['ln1_w'], prm['ln1_b'])
    h = x * (1 + sc2) + sh2
    f, conv_new = conv_ffn(h, conv_buf, prm['w_up'], prm['b_up'], prm['conv_w'], prm['conv_b'], prm['w_down'])
    x = layer_norm(ALPHA * x + g2 * f, prm['ln2_w'], prm['ln2_b'])
    dt = x.dtype
    return x, k_win, v_win, C.astype(dt), n.astype(dt), m.astype(dt), conv_new


def setup_inputs(seed: int = 0) -> dict:
    key = jax.random.key(seed)
    ks = jax.random.split(key, 32)
    L, D = DEPTH, D_MODEL

    def nrm(k, shape, s):
        return jax.random.normal(k, shape, jnp.float32) * s

    return {
        'x_prompt': nrm(ks[0], (BATCH, SEQ, D), 1.0),
        'x_sample': nrm(ks[1], (DEC_BATCH, DEC_SEQ, D), 1.0),
        'cache_attn_k': nrm(ks[2], (L, DEC_BATCH, KV_WIN, N_KV_A, HEAD_DIM_A), 1.0),
        'cache_attn_v': nrm(ks[3], (L, DEC_BATCH, KV_WIN, N_KV_A, HEAD_DIM_A), 1.0),
        'state_mlstm_C': nrm(ks[4], (L, DEC_BATCH, N_HEADS_B, DV_B, DQK_B), 0.1),
        'state_mlstm_n': nrm(ks[5], (L, DEC_BATCH, N_HEADS_B, DQK_B), 0.1),
        'state_mlstm_m': nrm(ks[6], (L, DEC_BATCH, N_HEADS_B), 0.5),
        'state_ffn_conv': nrm(ks[7], (L, DEC_BATCH, CONV_W - 1, 2 * D_FF), 1.0),
        'c_prompt': nrm(ks[8], (BATCH, D), 1.0),
        'c_sample': nrm(ks[9], (DEC_BATCH, D), 1.0),
        'w_ada': nrm(ks[10], (L, D, 6 * D), 0.5 * D ** -0.5),
        'b_ada': nrm(ks[11], (L, 6 * D), 0.01),
        'w_in': nrm(ks[12], (L, D, Z_WIDTH), D ** -0.5),
        'b_igate': nrm(ks[13], (L, N_HEADS_B), 0.1),
        'b_fgate': jnp.linspace(3.0, 6.0, N_HEADS_B, dtype=jnp.float32)[None] + nrm(ks[14], (L, N_HEADS_B), 0.1),
        'attn_sinks': nrm(ks[15], (L, N_HEADS_A), 0.5),
        'mlstm_norm_w': 1.0 + nrm(ks[16], (L, V_B), 0.02),
        'w_proj_a': nrm(ks[17], (L, Q_A, D), Q_A ** -0.5),
        'w_proj_b': nrm(ks[18], (L, V_B, D), V_B ** -0.5),
        'w_out': nrm(ks[19], (L, D, D), BETA * D ** -0.5),
        'ln1_w': 1.0 + nrm(ks[20], (L, D), 0.02),
        'ln1_b': nrm(ks[21], (L, D), 0.02),
        'w_up': nrm(ks[22], (L, D, 2 * D_FF), D ** -0.5),
        'b_up': nrm(ks[23], (L, 2 * D_FF), 0.01),
        'conv_w': nrm(ks[24], (L, CONV_W, 2 * D_FF), CONV_W ** -0.5),
        'conv_b': nrm(ks[25], (L, 2 * D_FF), 0.01),
        'w_down': nrm(ks[26], (L, D_FF, D), BETA * D_FF ** -0.5),
        'ln2_w': 1.0 + nrm(ks[27], (L, D), 0.02),
        'ln2_b': nrm(ks[28], (L, D), 0.02),
    }


def reference(x_prompt, x_sample, cache_attn_k, cache_attn_v, state_mlstm_C, state_mlstm_n, state_mlstm_m,
              state_ffn_conv, c_prompt, c_sample, w_ada, b_ada, w_in, b_igate, b_fgate, attn_sinks, mlstm_norm_w,
              w_proj_a, w_proj_b, w_out, ln1_w, ln1_b, w_up, b_up, conv_w, conv_b, w_down, ln2_w, ln2_b):
    Bp = x_prompt.shape[0]
    dec_t = x_sample.shape[1]
    y_prompt, y_sample = x_prompt, x_sample
    p_out, s_out = [], []
    for l in range(DEPTH):
        prm = dict(w_ada=w_ada[l], b_ada=b_ada[l], w_in=w_in[l], b_igate=b_igate[l], b_fgate=b_fgate[l],
                   attn_sinks=attn_sinks[l], mlstm_norm_w=mlstm_norm_w[l], w_proj_a=w_proj_a[l],
                   w_proj_b=w_proj_b[l], w_out=w_out[l], ln1_w=ln1_w[l], ln1_b=ln1_b[l], w_up=w_up[l],
                   b_up=b_up[l], conv_w=conv_w[l], conv_b=conv_b[l], w_down=w_down[l], ln2_w=ln2_w[l],
                   ln2_b=ln2_b[l])
        C0 = jnp.zeros((Bp, N_HEADS_B, DV_B, DQK_B), jnp.float32)
        n0 = jnp.zeros((Bp, N_HEADS_B, DQK_B), jnp.float32)
        m0 = jnp.zeros((Bp, N_HEADS_B), jnp.float32)
        conv0 = jnp.zeros((Bp, CONV_W - 1, 2 * D_FF), x_prompt.dtype)
        res_p = trunk_layer(y_prompt, c_prompt, None, None, C0, n0, m0, conv0, CHUNK, prm)
        y_prompt = res_p[0]
        p_out.append(res_p[1:])
        res_s = trunk_layer(y_sample, c_sample, cache_attn_k[l], cache_attn_v[l], state_mlstm_C[l],
                            state_mlstm_n[l], state_mlstm_m[l], state_ffn_conv[l], dec_t, prm)
        y_sample = res_s[0]
        s_out.append(res_s[1:])
    p_k, p_v, p_C, p_n, p_m, p_conv = [jnp.stack([o[i] for o in p_out]) for i in range(6)]
    s_k, s_v, s_C, s_n, s_m, s_conv = [jnp.stack([o[i] for o in s_out]) for i in range(6)]
    return (y_prompt, y_sample, p_k, p_v, p_C, p_n, p_m, p_conv, s_k, s_v, s_C, s_n, s_m, s_conv)
```

```cpp
#include <hip/hip_runtime.h>
#include <hip/hip_cooperative_groups.h>
#include <cstdio>
namespace cg = cooperative_groups;

#define DI __device__ __forceinline__
#define LAS __attribute__((address_space(3)))
typedef unsigned short bf16_t;
typedef short bf16x8 __attribute__((ext_vector_type(8)));
typedef short s16x4 __attribute__((ext_vector_type(4)));
typedef short v4i16_t __attribute__((ext_vector_type(4)));
typedef float f32x4 __attribute__((ext_vector_type(4)));
typedef float f32x2_t __attribute__((ext_vector_type(2)));
typedef __bf16 bf16x2_t __attribute__((ext_vector_type(2)));
typedef unsigned u32x4 __attribute__((ext_vector_type(4)));
typedef unsigned u32x2 __attribute__((ext_vector_type(2)));

constexpr int D = 1024, MP = 32768, MS = 1024, M = MP + MS, SEQ = 8192, DSEQ = 32;
constexpr int ZW = 6408, NZ = 6400, DFF = 2816, DFF2 = 5632;
constexpr float ALPHA = 1.189207115002721f;
constexpr float LN_EPS = 1e-5f;
constexpr size_t O_Y = 0;
constexpr size_t O_PK = (size_t)M * D;
constexpr size_t O_PV = O_PK + 65536;
constexpr size_t O_PC = O_PV + 65536;
constexpr size_t O_PN = O_PC + 524288;
constexpr size_t O_PM = O_PN + 2048;
constexpr size_t O_PCONV = O_PM + 16;
constexpr size_t O_SK = O_PCONV + 45056;
constexpr size_t O_SV = O_SK + 524288;
constexpr size_t O_SC = O_SV + 524288;
constexpr size_t O_SN = O_SC + 4194304;
constexpr size_t O_SM = O_SN + 16384;
constexpr size_t O_SCONV = O_SM + 128;
constexpr size_t WS_WIN = 0;
constexpr size_t WS_WPA = WS_WIN + (size_t)NZ * D * 2;
constexpr size_t WS_WPB = WS_WPA + (size_t)D * D * 2;
constexpr size_t WS_WO = WS_WPB + (size_t)D * D * 2;
constexpr size_t WS_MOD = WS_WO + (size_t)D * D * 2;
constexpr size_t WS_GI = WS_MOD + (size_t)36 * 6144 * 4;
constexpr size_t WS_GF = WS_GI + (size_t)M * 16;
constexpr size_t WS_MT = WS_GF + (size_t)M * 16;
constexpr size_t WS_BT = WS_MT + (size_t)M * 16;
constexpr size_t WS_CSN = WS_BT + (size_t)M * 16;
constexpr size_t WS_ZA = WS_CSN + (size_t)16 * 64 * 128 * 4;
constexpr size_t WS_ZB = WS_ZA + (size_t)M * 1280 * 2;
constexpr size_t WS_ZG = WS_ZB + (size_t)M * 2048 * 2;
constexpr size_t WS_CS = WS_ZG + (size_t)M * 3072 * 2;
constexpr size_t WS_END = WS_CS + (size_t)1024 * 32768 * 2;
constexpr size_t ZA_KA = (size_t)M * 1024 * 2, ZA_VA = ZA_KA + (size_t)2 * M * 64 * 2;
constexpr size_t ZB_KM = (size_t)4 * M * 128 * 2, ZB_VM = 2 * ZB_KM;
constexpr size_t ZG_GAB = (size_t)4 * M * 256 * 2;
constexpr size_t WS_WUP = WS_CS;
constexpr size_t WS_WD = WS_WUP + (size_t)DFF2 * D * 2;
constexpr size_t WS_MG = WS_ZA;
constexpr size_t WS_X1 = WS_ZB;
constexpr size_t WS_ACT = WS_ZG;
constexpr size_t WS_R1 = WS_ZG;
constexpr size_t WS_R2 = WS_ZA;
static_assert(WS_END <= 536870912, "ws");
constexpr size_t OY_H1 = 0;
constexpr size_t OY_YA = 0;
constexpr size_t OY_YB = (size_t)M * D * 2;
constexpr size_t OY_H2 = 1048576;

constexpr int LDS_BYTES = 147456;
constexpr int NPH = 12;

struct Params {
    const float* in[29];
    float* out;
    unsigned char* ws;
    int ph_lo, ph_hi;
};


constexpr int LDS_TAB = 146432;
DI const float* pin_ptr(LAS unsigned char* lds, int k) {
    const unsigned long long v = *(const LAS unsigned long long*)(lds + LDS_TAB + 8 * k);
    const unsigned lo = __builtin_amdgcn_readfirstlane((unsigned)v), hi = __builtin_amdgcn_readfirstlane((unsigned)(v >> 32));
    typedef const __attribute__((address_space(1))) float* gptr_t;
    const gptr_t g = (gptr_t)(((unsigned long long)hi << 32) | lo);
    return (const float*)g;
}
#define PIN(k) pin_ptr(lds, (k))
DI unsigned cvtpk(float lo, float hi) { f32x2_t v = {lo, hi}; bf16x2_t b = __builtin_convertvector(v, bf16x2_t); return __builtin_bit_cast(unsigned, b); }
DI float bflo(unsigned u) { return __uint_as_float(u << 16); }
DI float bfhi(unsigned u) { return __uint_as_float(u & 0xffff0000u); }
template <class T> DI T ntl(const T* p) { return __builtin_nontemporal_load(p); }
template <class T> DI void nts(T* p, T v) { __builtin_nontemporal_store(v, p); }
DI void swap16(unsigned& a, unsigned& b) { auto r = __builtin_amdgcn_permlane16_swap(a, b, false, false); a = r[0]; b = r[1]; }
DI void swap16x2(u32x4& v) { unsigned a = v.x, b = v.z; swap16(a, b); v.x = a; v.z = b; a = v.y; b = v.w; swap16(a, b); v.y = a; v.w = b; }
DI int opaque_tid() { int t = threadIdx.x; asm volatile("" : "+v"(t)); return t; }
DI float sigm(float x) { return __builtin_amdgcn_rcpf(1.f + __builtin_amdgcn_exp2f(-1.4426950408889634f * x)); }
DI s16x4 lds_tr(const LAS unsigned char* p) { return __builtin_bit_cast(s16x4, __builtin_amdgcn_ds_read_tr16_b64_v4i16((LAS v4i16_t*)p)); }
DI bf16x8 cat8(s16x4 lo, s16x4 hi) { return __builtin_shufflevector(lo, hi, 0, 1, 2, 3, 4, 5, 6, 7); }
DI float ror1(float v) { return __builtin_bit_cast(float, __builtin_amdgcn_update_dpp(0, __builtin_bit_cast(int, v), 0x121, 0xf, 0xf, false)); }
DI float ror2(float v) { return __builtin_bit_cast(float, __builtin_amdgcn_update_dpp(0, __builtin_bit_cast(int, v), 0x122, 0xf, 0xf, false)); }
DI float wave_sum(float v) {
#pragma unroll
    for (int o = 1; o < 64; o <<= 1) v += __shfl_xor(v, o);
    return v;
}
DI int crow_of(int row) { return row < MP ? (row >> 13) : 4 + ((row - MP) >> 5); }
DI const float* xrow_of(const float* xp, const float* xs, int row) { return row < MP ? xp + (size_t)row * D : xs + (size_t)(row - MP) * D; }
#define MFMA16(a, b, c) __builtin_amdgcn_mfma_f32_16x16x32_bf16((a), (b), (c), 0, 0, 0)

namespace pg8 {
constexpr int BM = 256, BK = 64, HALF = 128, HTB = HALF * BK * 2, NXCD = 8, WGM = 4;
DI int lds_byte(int r, int c) { const int st = (r >> 4) * 2 + (c >> 5), rr = r & 15, cc = c & 31, ob = rr * 64 + cc * 2; return st * 1024 + (ob ^ (((ob >> 9) & 1) << 5)); }
DI void stage_rc(int b, int& R, int& C) { const int st = b / 1024, sb = b % 1024, swz = sb ^ (((sb >> 9) & 1) << 5); R = (st >> 1) * 16 + swz / 64; C = (st & 1) * 32 + (swz % 64) / 2; }
DI int perm32(int rho) { const int n = rho >> 4, i = rho & 15; return 8 * (i >> 2) + 4 * n + (i & 3); }
struct Unit { int pm, pn; };
struct Gemm { const bf16_t* A; const bf16_t* Bt; int K; };
template <int NM, int NN, int MODE> struct Sched {
    static constexpr int nM = NM, nN = NN, nwg = NM * NN;
    DI bool next(int i, Unit& u) const {
        const int G = gridDim.x, c = blockIdx.x;
        const long L = (long)i * G + c; if (L >= nwg) return false;
        int wgid = (int)L; { constexpr int q = nwg / NXCD, r = nwg % NXCD; const int xcd = wgid % NXCD, off = wgid / NXCD; wgid = (xcd < r ? xcd * (q + 1) : r * (q + 1) + (xcd - r) * q) + off; }
        constexpr int nig = WGM * nN; const int gid = wgid / nig, fm = gid * WGM, gsz = (nM - fm) < WGM ? (nM - fm) : WGM;
        u.pm = fm + ((wgid % nig) % gsz); u.pn = (wgid % nig) / gsz; return true;
    }
    DI long arow(const Unit& u) const {
        if (MODE == 0) return (long)u.pm * BM;
        if (u.pm < 132) { const int s = u.pm / 33, i = u.pm - s * 33; return (long)s * SEQ + 254 * i - 2; }
        return (long)MP + (long)(u.pm - 132) * BM;
    }
};

template <class Epi, bool ALIGN_EPI, int NM, int NN, int MODE, int KK, bool ROWPERM = false>
DI void gemm_phase(LAS unsigned char* lds, const bf16_t* gA, const bf16_t* gBt, const Epi& E) {
    const Sched<NM, NN, MODE> S;
    const int tid = opaque_tid(), wid = __builtin_amdgcn_readfirstlane(tid >> 6), lane = tid & 63, wr = wid >> 2, wc = wid & 3, fr = lane & 15, fq = lane >> 4;
    constexpr int K = KK, nt = K / BK;
    unsigned voffA[2], voffB[2];
#pragma unroll
    for (int i = 0; i < 2; ++i) { int R, C; stage_rc(tid * 16 + i * 8192, R, C); const int Rb = (R & ~31) + perm32(R & 31);
        const int Ra = ROWPERM ? (128 * (R >> 6) + (R & 63)) : R;
        voffA[i] = (unsigned)(Ra * K + C) * 2u; voffB[i] = (unsigned)(Rb * K + C) * 2u; }
    const size_t kstep = (size_t)(BK * 2);
    const size_t hstep = (size_t)HALF * K * 2;
    const size_t hstepA = ROWPERM ? (size_t)64 * K * 2 : hstep;
    const size_t tstep = 2 * hstep;
    const long rowb = (long)K * 2;
    const unsigned ldsw = (unsigned)wid * 1024u;
    const int aoff = lds_byte(wr * 64 + fr, fq * 8), boff = lds_byte(wc * 32 + fr, fq * 8);
#define PG8_SA(b, h) (((b) * 2 + (h)) * HTB)
#define PG8_SB(b, h) ((4 + (b) * 2 + (h)) * HTB)
#define PG8_STAGE(bufoff, gbase, voff) do { _Pragma("unroll") for (int _i = 0; _i < 2; ++_i) \
        __builtin_amdgcn_global_load_lds((const unsigned*)((const char*)(gbase) + (voff)[_i]), (LAS unsigned*)(lds + (bufoff) + ldsw + _i * 8192), 16, 0, 0); } while (0)
#define PG8_LDA(dst, b, h) do { _Pragma("unroll") for (int m = 0; m < 4; ++m) _Pragma("unroll") for (int k = 0; k < 2; ++k) dst[m][k] = *(const LAS bf16x8*)(lds + PG8_SA(b, h) + aoff + m * 2048 + k * 1024); } while (0)
#define PG8_LDB(dst, b, h) do { _Pragma("unroll") for (int n = 0; n < 2; ++n) _Pragma("unroll") for (int k = 0; k < 2; ++k) dst[n][k] = *(const LAS bf16x8*)(lds + PG8_SB(b, h) + boff + n * 2048 + k * 1024); } while (0)
#define PG8_MMA(ai, bj, At, Bt) do { __builtin_amdgcn_s_setprio(1); _Pragma("unroll") for (int m = 0; m < 4; ++m) _Pragma("unroll") for (int n = 0; n < 2; ++n) _Pragma("unroll") for (int k = 0; k < 2; ++k) \
        acc[ai][bj][m][n] = __builtin_amdgcn_mfma_f32_16x16x32_bf16(Bt[n][k], At[m][k], acc[ai][bj][m][n], 0, 0, 0); __builtin_amdgcn_s_setprio(0); } while (0)
#define PG8_WAIT_V(n) asm volatile("s_waitcnt vmcnt(" #n ")" ::: "memory")
#define PG8_WAIT_L(n) asm volatile("s_waitcnt lgkmcnt(" #n ")" ::: "memory")
#define PG8_BAR __builtin_amdgcn_s_barrier()
#define PG8_SCHED __builtin_amdgcn_sched_barrier(0)
    Unit cur, nxt; int ui = 0;
    if (!S.next(0, cur)) return;
    f32x4 acc[2][2][4][2];
#pragma unroll
    for (int a = 0; a < 2; ++a)
#pragma unroll
        for (int b = 0; b < 2; ++b)
#pragma unroll
            for (int m = 0; m < 4; ++m)
#pragma unroll
                for (int n = 0; n < 2; ++n) acc[a][b][m][n] = (f32x4){0.f, 0.f, 0.f, 0.f};
    bf16x8 At[4][2], B0[2][2], B1[2][2];
    const char* cA = (const char*)gA + S.arow(cur) * rowb; const char* cB = (const char*)gBt + (size_t)cur.pn * tstep;
    PG8_STAGE(PG8_SB(0, 0), cB, voffB); PG8_STAGE(PG8_SB(0, 1), cB + hstep, voffB); PG8_STAGE(PG8_SA(0, 0), cA, voffA); PG8_STAGE(PG8_SA(0, 1), cA + hstepA, voffA);
    if (wr == 1) PG8_BAR;
    PG8_WAIT_V(2); PG8_BAR;
    PG8_STAGE(PG8_SB(1, 0), cB + kstep, voffB); PG8_STAGE(PG8_SA(1, 0), cA + kstep, voffA); PG8_STAGE(PG8_SB(1, 1), cB + hstep + kstep, voffB);
    PG8_WAIT_V(6); PG8_BAR;
    for (;;) {
        const bool has_next = S.next(ui + 1, nxt);
        const char* nA = has_next ? (const char*)gA + S.arow(nxt) * rowb : cA; const char* nB = has_next ? (const char*)gBt + (size_t)nxt.pn * tstep : cB;
        for (int t = 0; t < nt; t += 2) {
            const bool last = (t == nt - 2);
            const char* a1 = cA + (size_t)(t + 1) * kstep;
            const char* a2 = last ? nA : cA + (size_t)(t + 2) * kstep; const char* b2 = last ? nB : cB + (size_t)(t + 2) * kstep;
            const char* a3 = a2 + kstep; const char* b3 = b2 + kstep;
            PG8_LDB(B0, 0, 0); PG8_LDB(B1, 0, 1); PG8_SCHED; PG8_LDA(At, 0, 0); PG8_STAGE(PG8_SA(1, 1), a1 + hstepA, voffA);
            PG8_WAIT_V(8); PG8_WAIT_L(0); PG8_BAR; PG8_MMA(0, 0, At, B0); PG8_MMA(0, 1, At, B1); PG8_BAR; PG8_SCHED;
            PG8_LDA(At, 0, 1); PG8_STAGE(PG8_SB(0, 0), b2, voffB); PG8_STAGE(PG8_SB(0, 1), b2 + hstep, voffB); PG8_STAGE(PG8_SA(0, 0), a2, voffA);
            PG8_WAIT_V(8); PG8_WAIT_L(0); PG8_BAR; PG8_MMA(1, 0, At, B0); PG8_MMA(1, 1, At, B1); PG8_BAR; PG8_SCHED;
            PG8_LDB(B0, 1, 0); PG8_LDB(B1, 1, 1); PG8_SCHED; PG8_LDA(At, 1, 0); PG8_STAGE(PG8_SA(0, 1), a2 + hstepA, voffA);
            PG8_WAIT_V(8); PG8_WAIT_L(0); PG8_BAR; PG8_MMA(0, 0, At, B0); PG8_MMA(0, 1, At, B1); PG8_BAR; PG8_SCHED;
            PG8_LDA(At, 1, 1); PG8_STAGE(PG8_SB(1, 0), b3, voffB); PG8_STAGE(PG8_SB(1, 1), b3 + hstep, voffB); PG8_STAGE(PG8_SA(1, 0), a3, voffA);
            PG8_WAIT_V(8); PG8_WAIT_L(0); PG8_BAR; PG8_MMA(1, 0, At, B0); PG8_MMA(1, 1, At, B1); PG8_BAR; PG8_SCHED;
        }
        if constexpr (ALIGN_EPI) { if (wr == 0) PG8_BAR; }
        E(acc, cur, wr, wc, fr, fq);
        if (!has_next) break;
#pragma unroll
        for (int a = 0; a < 2; ++a)
#pragma unroll
            for (int b = 0; b < 2; ++b)
#pragma unroll
                for (int m = 0; m < 4; ++m)
#pragma unroll
                    for (int n = 0; n < 2; ++n) acc[a][b][m][n] = (f32x4){0.f, 0.f, 0.f, 0.f};
        cur = nxt; cA = nA; cB = nB; ++ui;
        if constexpr (ALIGN_EPI) { if (wr == 1) PG8_BAR; }
    }
    PG8_WAIT_V(0);
    if constexpr (!ALIGN_EPI) { if (wr == 0) PG8_BAR; }
    PG8_BAR;
#undef PG8_SA
#undef PG8_SB
#undef PG8_STAGE
#undef PG8_LDA
#undef PG8_LDB
#undef PG8_MMA
#undef PG8_WAIT_V
#undef PG8_WAIT_L
#undef PG8_BAR
#undef PG8_SCHED
}
}
using pg8::Unit;
typedef f32x4 AccT[2][2][4][2];

struct EpiWin {
    unsigned char* ws; float* out;
    DI void operator()(const AccT& acc, const Unit& u, int wr, int wc, int fr, int fq) const {
        asm volatile("" : "+v"(fr), "+v"(fq));
        const int pn = u.pn; const int row0 = u.pm * 256 + wr * 64 + fr;
        const int c128 = wc * 32 + 8 * fq;
        bf16_t* base0; unsigned bjoff = 128, rstride; float sc = 1.f; bool sg = false;
        if (pn < 4) { base0 = (bf16_t*)(ws + WS_ZA) + pn * 256 + c128; rstride = 1024; }
        else if (pn == 4) { const int kvh = c128 >> 6, d = c128 & 63; base0 = (bf16_t*)(ws + WS_ZA + ZA_KA) + (size_t)kvh * M * 64 + d; bjoff = (unsigned)((ZA_VA - ZA_KA) / 2); rstride = 64; }
        else if (pn < 9) { const int hb = ((pn - 5) & 1) * 2; base0 = (bf16_t*)(ws + WS_ZB + (pn >= 7 ? ZB_KM : 0)) + (size_t)hb * M * 128 + c128; bjoff = (unsigned)M * 128u; rstride = 128; if (pn >= 7) sc = 0.08838834764831845f; }
        else if (pn < 13) { base0 = (bf16_t*)(ws + WS_ZB + ZB_VM) + (size_t)(pn - 9) * M * 256 + c128; rstride = 256; }
        else if (pn < 17) { base0 = (bf16_t*)(ws + WS_ZG) + (size_t)(pn - 13) * M * 256 + c128; rstride = 256; sg = true; }
        else { base0 = (bf16_t*)(ws + WS_ZG + ZG_GAB) + (pn - 17) * 256 + c128; rstride = 2048; sg = true; }
#pragma unroll
        for (int ai = 0; ai < 2; ++ai)
#pragma unroll
            for (int m = 0; m < 4; ++m) {
                const int row = row0 + ai * 128 + m * 16;
#pragma unroll
                for (int bj = 0; bj < 2; ++bj) {
                    f32x4 v0 = acc[ai][bj][m][0], v1 = acc[ai][bj][m][1];
                    if (pn == 4) {
                        float* dst = nullptr;
                        if (row < MP) { const int n = row >> 13, t = row & 8191; if (t >= SEQ - 128) dst = out + (bj ? O_PV : O_PK) + ((size_t)(n * 128 + t - (SEQ - 128))) * 128 + c128; }
                        else { const int rs = row - MP, n = rs >> 5, t = rs & 31; dst = out + (bj ? O_SV : O_SK) + ((size_t)(n * 128 + 96 + t)) * 128 + c128; }
                        if (dst) { *(f32x4*)dst = v0; *(f32x4*)(dst + 4) = v1; }
                    }
                    if (sg) {
#pragma unroll
                        for (int e = 0; e < 4; ++e) { v0[e] = sigm(v0[e]); v1[e] = sigm(v1[e]); }
                    } else { v0 = v0 * sc; v1 = v1 * sc; }
                    u32x4 w; w.x = cvtpk(v0[0], v0[1]); w.y = cvtpk(v0[2], v0[3]); w.z = cvtpk(v1[0], v1[1]); w.w = cvtpk(v1[2], v1[3]);
                    *(u32x4*)(base0 + ((size_t)row * rstride + (bj ? bjoff : 0u))) = w;
                }
            }
    }
};
template <int WHICH> struct EpiProj {
    unsigned char* ws;
    DI void operator()(const AccT& acc, const Unit& u, int wr, int wc, int fr, int fq) const {
        bf16_t* MG = (bf16_t*)(ws + WS_MG); const bf16_t* zG = (const bf16_t*)(ws + WS_ZG + ZG_GAB);
        const int row0 = u.pm * 256 + wr * 64 + fr, col0 = u.pn * 256 + wc * 32 + 8 * fq;
#pragma unroll
        for (int ai = 0; ai < 2; ++ai) {
            u32x4 gt[4][2], od[4][2];
#pragma unroll
            for (int m = 0; m < 4; ++m)
#pragma unroll
                for (int bj = 0; bj < 2; ++bj) {
                    const unsigned row = row0 + ai * 128 + m * 16, col = col0 + bj * 128;
                    gt[m][bj] = ntl((const u32x4*)(zG + (size_t)(row * 2048u + WHICH * 1024u + col)));
                    if (WHICH == 1) od[m][bj] = *(const u32x4*)(MG + (size_t)(row * 1024u + col));
                }
#pragma unroll
            for (int m = 0; m < 4; ++m)
#pragma unroll
                for (int bj = 0; bj < 2; ++bj) {
                    const unsigned row = row0 + ai * 128 + m * 16, col = col0 + bj * 128;
                    const u32x4 g = gt[m][bj];
                    f32x4 v0 = acc[ai][bj][m][0], v1 = acc[ai][bj][m][1];
                    v0[0] *= bflo(g.x); v0[1] *= bfhi(g.x); v0[2] *= bflo(g.y); v0[3] *= bfhi(g.y);
                    v1[0] *= bflo(g.z); v1[1] *= bfhi(g.z); v1[2] *= bflo(g.w); v1[3] *= bfhi(g.w);
                    if (WHICH == 1) { const u32x4 o = od[m][bj];
                        v0[0] += bflo(o.x); v0[1] += bfhi(o.x); v0[2] += bflo(o.y); v0[3] += bfhi(o.y);
                        v1[0] += bflo(o.z); v1[1] += bfhi(o.z); v1[2] += bflo(o.w); v1[3] += bfhi(o.w); }
                    u32x4 w; w.x = cvtpk(v0[0], v0[1]); w.y = cvtpk(v0[2], v0[3]); w.z = cvtpk(v1[0], v1[1]); w.w = cvtpk(v1[2], v1[3]);
                    *(u32x4*)(MG + (size_t)(row * 1024u + col)) = w;
                }
        }
    }
};
template <int V> struct EpiRes {
    unsigned char* ws; float* out; LAS unsigned char* lds;
    DI void operator()(const AccT& acc, const Unit& u, int wr, int wc, int fr, int fq) const {
        bf16_t* dst = (bf16_t*)(ws + (V == 0 ? WS_R1 : WS_R2));
        const float* mod = (const float*)(ws + WS_MOD); constexpr int goff = V == 0 ? 2048 : 5120;
        const int row0 = u.pm * 256 + wr * 64 + fr, col0 = u.pn * 256 + wc * 32 + 8 * fq;
        const bool uni = u.pm < 128;
        f32x4 gu[2][2];
        if (uni) { const float* gp = mod + (size_t)(u.pm >> 5) * 6144 + goff + col0;
#pragma unroll
            for (int bj = 0; bj < 2; ++bj)
#pragma unroll
                for (int n = 0; n < 2; ++n) gu[bj][n] = *(const f32x4*)(gp + bj * 128 + 4 * n); }
#pragma unroll
        for (int ai = 0; ai < 2; ++ai)
#pragma unroll
            for (int m = 0; m < 4; ++m) {
                const int row = row0 + ai * 128 + m * 16;
                const float* gp = mod + (size_t)crow_of(row) * 6144 + goff + col0;
#pragma unroll
                for (int bj = 0; bj < 2; ++bj) {
                    const f32x4 g0 = uni ? gu[bj][0] : *(const f32x4*)(gp + bj * 128), g1 = uni ? gu[bj][1] : *(const f32x4*)(gp + bj * 128 + 4);
                    const f32x4 v0 = g0 * acc[ai][bj][m][0], v1 = g1 * acc[ai][bj][m][1];
                    u32x4 w; w.x = cvtpk(v0[0], v0[1]); w.y = cvtpk(v0[2], v0[3]); w.z = cvtpk(v1[0], v1[1]); w.w = cvtpk(v1[2], v1[3]);
                    *(u32x4*)(dst + (size_t)row * D + col0 + bj * 128) = w;
                }
            }
    }
};
struct EpiUp {
    unsigned char* ws; float* out; LAS unsigned char* lds;
    DI void operator()(const AccT& acc, const Unit& u, int wr, int wc, int fr, int fq) const {
        bf16_t* act = (bf16_t*)(ws + WS_ACT); const float* b_up = PIN(23); const float* conv_w = PIN(24); const float* conv_b = PIN(25); const float* st_conv = PIN(7); LAS float* bnd = (LAS float*)(lds + 131072);
        const bool sample = u.pm >= 132;
        int seq = 0, tbase = 0;
        if (!sample) { seq = u.pm / 33; tbase = 254 * (u.pm - seq * 33) - 2; }
        const int cc = wc * 32 + 8 * fq;
        const int ca = u.pn * 128 + cc;
        LAS float* kc = (LAS float*)(lds + 131072 + 4096);
        {
            const int t = threadIdx.x;
#pragma unroll
            for (int i = 0; i < 3; ++i) { const int idx = t + 512 * i;
                if (idx < 1280) { const int arr = idx >> 7, c = idx & 127;
                    const float* src = arr < 2 ? b_up + arr * DFF : arr < 8 ? conv_w + (arr < 5 ? (arr - 2) * DFF2 : (arr - 5) * DFF2 + DFF) : conv_b + (arr - 8) * DFF;
                    kc[idx] = src[u.pn * 128 + c]; } }
        }
        if (wr == 0 && fr >= 14) {
#pragma unroll
            for (int bj = 0; bj < 2; ++bj)
#pragma unroll
                for (int n = 0; n < 2; ++n) {
                    *(LAS f32x4*)(bnd + ((fr - 14) * 256 + bj * 128 + cc + 4 * n)) = acc[1][bj][3][n] + *(const f32x4*)(b_up + bj * DFF + ca + 4 * n);
                }
        }
        __syncthreads();
#pragma unroll
        for (int n = 0; n < 2; ++n) {
            const int col = ca + 4 * n;
            const LAS float* kq = kc + cc + 4 * n;
            const f32x4 ba = *(const LAS f32x4*)kq, bg = *(const LAS f32x4*)(kq + 128), w0a = *(const LAS f32x4*)(kq + 256), w1a = *(const LAS f32x4*)(kq + 384), w2a = *(const LAS f32x4*)(kq + 512),
                        w0g = *(const LAS f32x4*)(kq + 640), w1g = *(const LAS f32x4*)(kq + 768), w2g = *(const LAS f32x4*)(kq + 896), cba = *(const LAS f32x4*)(kq + 1024), cbg = *(const LAS f32x4*)(kq + 1152);
            f32x4 c1a, c2a, c1g, c2g;
#pragma unroll
            for (int ai = 0; ai < 2; ++ai) {
                if (ai == 0) {
                    c1a = (f32x4){0.f, 0.f, 0.f, 0.f}; c2a = c1a; c1g = c1a; c2g = c1a;
                    if (wr == 1) {
                        const LAS float* b14 = bnd + cc + 4 * n;
                        const LAS float* b15 = b14 + 256;
                        const f32x4 r14a = *(const LAS f32x4*)b14, r15a = *(const LAS f32x4*)b15, r14g = *(const LAS f32x4*)(b14 + 128), r15g = *(const LAS f32x4*)(b15 + 128);
                        c1a = r15a; c1g = r15g;
#pragma unroll
                        for (int e = 0; e < 4; ++e) { c2a[e] = fr == 0 ? r14a[e] : r15a[e]; c2g[e] = fr == 0 ? r14g[e] : r15g[e]; }
                    }
                }
#pragma unroll
                for (int m = 0; m < 4; ++m) {
                    const int tr = 128 * wr + 64 * ai + 16 * m + fr;
                    const int tl = sample ? ((16 * m + fr) & 31) : tbase + tr;
                    f32x4 va = acc[ai][0][m][n] + ba, vg = acc[ai][1][m][n] + bg;
                    if (!sample && tl < 0) { va = (f32x4){0.f, 0.f, 0.f, 0.f}; vg = va; }
                    int ns = 0;
                    if (sample) {
                        ns = ((u.pm - 132) * 256 + 128 * wr + 64 * ai + 16 * m) >> 5;
                        if ((m & 1) == 0) {
                            const float* s0 = st_conv + (size_t)(ns * 2) * DFF2 + col;
                            const f32x4 s0a = *(const f32x4*)s0, s1a = *(const f32x4*)(s0 + DFF2), s0g = *(const f32x4*)(s0 + DFF), s1g = *(const f32x4*)(s0 + DFF2 + DFF);
                            c1a = s1a; c1g = s1g;
#pragma unroll
                            for (int e = 0; e < 4; ++e) { c2a[e] = fr == 0 ? s0a[e] : s1a[e]; c2g[e] = fr == 0 ? s0g[e] : s1g[e]; }
                        }
                    }
                    f32x4 t1a, t2a, t1g, t2g, res;
#pragma unroll
                    for (int e = 0; e < 4; ++e) {
                        t1a[e] = ror1(va[e]); t2a[e] = ror2(va[e]); t1g[e] = ror1(vg[e]); t2g[e] = ror2(vg[e]);
                        const float p1a = fr >= 1 ? t1a[e] : c1a[e], p2a = fr >= 2 ? t2a[e] : c2a[e];
                        const float p1g = fr >= 1 ? t1g[e] : c1g[e], p2g = fr >= 2 ? t2g[e] : c2g[e];
                        const float ua = cba[e] + w0a[e] * p2a + w1a[e] * p1a + w2a[e] * va[e];
                        const float ug = cbg[e] + w0g[e] * p2g + w1g[e] * p1g + w2g[e] * vg[e];
                        const float y2 = 1.5957691216057308f * (ug + 0.044715f * ug * ug * ug);
                        res[e] = ua * ug * sigm(y2);
                    }
                    c1a = t1a; c2a = t2a; c1g = t1g; c2g = t2g;
                    const bool valid = sample ? true : (tr >= 2 && tl < SEQ);
                    if (valid) {
                        const size_t grow = sample ? (size_t)MP + (size_t)(u.pm - 132) * 256 + tr : (size_t)seq * SEQ + tl;
                        u32x2 w; w.x = cvtpk(res[0], res[1]); w.y = cvtpk(res[2], res[3]);
                        *(u32x2*)(act + grow * DFF + col) = w;
                        const int lastt = sample ? DSEQ - 2 : SEQ - 2;
                        if (tl >= lastt) {
                            float* dst = sample ? out + O_SCONV + (size_t)(ns * 2 + (tl - lastt)) * DFF2 + col : out + O_PCONV + (size_t)(seq * 2 + (tl - lastt)) * DFF2 + col;
                            *(f32x4*)dst = va; *(f32x4*)(dst + DFF) = vg;
                        }
                    }
                }
            }
        }
    }
};

DI void wtrans_item(const float* W, int ldw, int k0, int n0src, bf16_t* WT, int ldt, int n0dst, LAS float* scr, int lane) {
    f32x4 tv[8];
#pragma unroll
    for (int i = 0; i < 8; ++i) { const int kk = 8 * i + (lane >> 3); tv[i] = ntl((const f32x4*)(W + (size_t)(k0 + kk) * ldw + n0src + 4 * (lane & 7))); }
#pragma unroll
    for (int i = 0; i < 8; ++i) { const int kk = 8 * i + (lane >> 3); LAS float* d = scr + kk * 33 + 4 * (lane & 7); d[0] = tv[i][0]; d[1] = tv[i][1]; d[2] = tv[i][2]; d[3] = tv[i][3]; }
    asm volatile("s_waitcnt lgkmcnt(0)" ::: "memory");
    const int c = lane & 7;
#pragma unroll
    for (int j = 0; j < 4; ++j) { const int n = (lane >> 3) + 8 * j; const LAS float* s = scr + (8 * c) * 33 + n;
        u32x4 o; o.x = cvtpk(s[0], s[33]); o.y = cvtpk(s[2 * 33], s[3 * 33]); o.z = cvtpk(s[4 * 33], s[5 * 33]); o.w = cvtpk(s[6 * 33], s[7 * 33]);
        *(u32x4*)(WT + (size_t)(n0dst + n) * ldt + k0 + 8 * c) = o; }
    asm volatile("s_waitcnt lgkmcnt(0)" ::: "memory");
}
DI void mod_item(const Params& p, LAS unsigned char* lds, int ci, int tid) {
    LAS float* sc = (LAS float*)lds;
    LAS float* red = (LAS float*)(lds + 40960);
    LAS float* wt = (LAS float*)(lds + 40960);
    const float* w_ada = PIN(10); const float* b_ada = PIN(11); const float* cp = PIN(8); const float* cs = PIN(9);
    float* mod = (float*)(p.ws + WS_MOD);
    const int col = tid & 31, kg = tid >> 5, col0 = ci * 32;
    float acc[36];
#pragma unroll
    for (int r = 0; r < 36; ++r) acc[r] = 0.f;
    for (int ch = 0; ch < 4; ++ch) {
        __syncthreads();
#pragma unroll 6
        for (int i = 0; i < 18; ++i) { const int idx = tid + 512 * i, r = idx >> 8, kk = idx & 255;
            const float c = r < 4 ? cp[r * D + ch * 256 + kk] : cs[(r - 4) * D + ch * 256 + kk];
            sc[kk * 36 + r] = c * sigm(c); }
        {
            f32x4 wt4[4];
#pragma unroll
            for (int i = 0; i < 4; ++i) { const int idx4 = tid + 512 * i; wt4[i] = ntl((const f32x4*)(w_ada + (size_t)(ch * 256 + (idx4 >> 3)) * 6144 + col0 + 4 * (idx4 & 7))); }
#pragma unroll
            for (int i = 0; i < 4; ++i) { const int idx4 = tid + 512 * i; *(LAS f32x4*)(wt + (idx4 >> 3) * 32 + 4 * (idx4 & 7)) = wt4[i]; }
        }
        __syncthreads();
#pragma unroll
        for (int kk = 0; kk < 16; ++kk) {
            const float w = wt[(kg * 16 + kk) * 32 + col];
            const LAS f32x4* s = (const LAS f32x4*)(sc + (kg * 16 + kk) * 36);
#pragma unroll
            for (int q = 0; q < 9; ++q) { const f32x4 v = s[q]; acc[4 * q] += v[0] * w; acc[4 * q + 1] += v[1] * w; acc[4 * q + 2] += v[2] * w; acc[4 * q + 3] += v[3] * w; }
        }
    }
    __syncthreads();
#pragma unroll
    for (int r = 0; r < 36; ++r) red[(kg * 36 + r) * 32 + col] = acc[r];
    __syncthreads();
    for (int o = tid; o < 36 * 32; o += 512) { const int r = o >> 5, cc = o & 31; float sum = b_ada[col0 + cc];
#pragma unroll
        for (int q = 0; q < 16; ++q) sum += red[(q * 36 + r) * 32 + cc];
        mod[(size_t)r * 6144 + col0 + cc] = sum; }
    __syncthreads();
}
DI void phase0a(const Params& p, LAS unsigned char* lds) {
    const int tid = opaque_tid(), lane = tid & 63, wave = tid >> 6;
    for (int it = blockIdx.x; it < 192; it += gridDim.x) mod_item(p, lds, it, tid);
    LAS float* scr = (LAS float*)(lds + wave * 8448);
    constexpr int I_WIN = 16 * 200, I_SQ = 16 * 32;
    constexpr int NIT = I_WIN + 3 * I_SQ;
    const float* w_in = PIN(12);
    for (int it = blockIdx.x * 8 + wave; it < NIT; it += gridDim.x * 8) {
        int r = it;
        if (r < I_WIN) { const int kb = r / 200, nb = r - kb * 200; const int n0 = nb * 32; wtrans_item(w_in, ZW, kb * 64, n0 < 3328 ? n0 : n0 + 8, (bf16_t*)(p.ws + WS_WIN), D, n0, scr, lane); continue; } r -= I_WIN;
        const int which = r / I_SQ; r -= which * I_SQ;
        const float* W = which == 0 ? PIN(17) : which == 1 ? PIN(18) : PIN(19);
        bf16_t* WT = (bf16_t*)(p.ws + (which == 0 ? WS_WPA : which == 1 ? WS_WPB : WS_WO));
        wtrans_item(W, D, (r >> 5) * 64, (r & 31) * 32, WT, D, (r & 31) * 32, scr, lane);
    }
}
DI void phase0b(const Params& p, LAS unsigned char* lds) {
    const int tid = opaque_tid(), lane = tid & 63, wave = tid >> 6;
    LAS float* wg = (LAS float*)lds;
    for (int i = tid; i < 8192; i += 512) { const int k = i >> 3, g = i & 7; const int chunk = k >> 2;
        wg[g * 1024 + ((chunk & 1) ? 512 : 0) + (chunk >> 1) * 4 + (k & 3)] = PIN(12)[(size_t)k * ZW + 3328 + g]; }
    __syncthreads();
    const float* mod = (const float*)(p.ws + WS_MOD);
    bf16_t* h1 = (bf16_t*)((unsigned char*)p.out + OY_H1);
    float* GI = (float*)(p.ws + WS_GI); float* GF = (float*)(p.ws + WS_GF);
    const float* xp0 = PIN(0); const float* xs0 = PIN(1); const float* bi_g = PIN(13); const float* bf_g = PIN(14);
    for (int rp = blockIdx.x * 8 + wave; rp < M / 2; rp += gridDim.x * 8) {
        float a8[2][8];
#pragma unroll
        for (int q = 0; q < 2; ++q)
#pragma unroll
            for (int g = 0; g < 8; ++g) a8[q][g] = 0.f;
#pragma unroll
        for (int q = 0; q < 2; ++q) {
            const int row = rp * 2 + q;
            const float* xr = xrow_of(xp0, xs0, row); const float* mr = mod + (size_t)crow_of(row) * 6144;
#pragma unroll
            for (int i = 0; i < 2; ++i) {
                const int c = 8 * lane + 512 * i;
                const f32x4 xa = ntl((const f32x4*)(xr + c)), xb = ntl((const f32x4*)(xr + c + 4));
                const f32x4 ha = xa * (*(const f32x4*)(mr + 1024 + c) + 1.f) + *(const f32x4*)(mr + c);
                const f32x4 hb = xb * (*(const f32x4*)(mr + 1024 + c + 4) + 1.f) + *(const f32x4*)(mr + c + 4);
                u32x4 w; w.x = cvtpk(ha[0], ha[1]); w.y = cvtpk(ha[2], ha[3]); w.z = cvtpk(hb[0], hb[1]); w.w = cvtpk(hb[2], hb[3]);
                *(u32x4*)(h1 + (size_t)row * D + c) = w;
                const int wo = (lane + 64 * i) * 4;
#pragma unroll
                for (int g = 0; g < 8; ++g) { const f32x4 wa = *(const LAS f32x4*)(wg + g * 1024 + wo), wb = *(const LAS f32x4*)(wg + g * 1024 + 512 + wo);
                    a8[q][g] += (ha[0] * wa[0] + ha[1] * wa[1] + ha[2] * wa[2] + ha[3] * wa[3]) + (hb[0] * wb[0] + hb[1] * wb[1] + hb[2] * wb[2] + hb[3] * wb[3]); }
            }
        }
#pragma unroll
        for (int q = 0; q < 2; ++q)
#pragma unroll
            for (int g = 0; g < 8; ++g) a8[q][g] = wave_sum(a8[q][g]);
        if (lane < 16) {
            const int q = lane >> 3, gl = lane & 7;
            float v = 0.f;
#pragma unroll
            for (int qq = 0; qq < 2; ++qq)
#pragma unroll
                for (int g = 0; g < 8; ++g) v = (q == qq && gl == g) ? a8[qq][g] : v;
            const int row = rp * 2 + q;
            if (gl < 4) GI[(size_t)row * 4 + gl] = v + bi_g[gl];
            else { const float xx = v + bf_g[gl - 4]; GF[(size_t)row * 4 + gl - 4] = fminf(xx, 0.f) - log1pf(__expf(-fabsf(xx))); }
        }
    }
    for (int i = blockIdx.x * 512 + tid; i < 32 * 96 * 32; i += gridDim.x * 512) {
        const int n = i / (96 * 32), rem = i - n * (96 * 32);
        const size_t so = ((size_t)n * 128 + 32) * 128 + (size_t)rem * 4, dof = (size_t)n * 128 * 128 + (size_t)rem * 4;
        *(f32x4*)(p.out + O_SK + dof) = *(const f32x4*)(PIN(2) + so);
        *(f32x4*)(p.out + O_SV + dof) = *(const f32x4*)(PIN(3) + so);
    }
}
DI void scan_step(float& A, float& C, int lane) {
#pragma unroll
    for (int off = 1; off < 64; off <<= 1) {
        const float Ap = __shfl_up(A, off), Cp = __shfl_up(C, off);
        if (lane >= off) { C = fmaxf(Cp + A, C); A = Ap + A; }
    }
}
DI void mscan(const Params& p, LAS unsigned char* lds) {
    const int tid = opaque_tid(), lane = tid & 63, wave = tid >> 6;
    const int G = gridDim.x, rb = G - 1 - (int)blockIdx.x;
    const float* GI = (const float*)(p.ws + WS_GI); const float* GF = (const float*)(p.ws + WS_GF);
    float* MT = (float*)(p.ws + WS_MT); float* BT = (float*)(p.ws + WS_BT);
    LAS float* la = (LAS float*)lds; LAS float* lc = la + SEQ;
    for (int ch = rb; ch < 16; ch += G) {
        const int n = ch >> 2, hh = ch & 3;
        __syncthreads();
        for (int t = tid; t < SEQ; t += 512) { const size_t r = ((size_t)n * SEQ + t) * 4 + hh; la[t] = GF[r]; lc[t] = GI[r]; }
        __syncthreads();
        if (wave == 0) {
            float mcar = 0.f, bcar = 0.f;
            for (int it = 0; it < SEQ / 64; ++it) {
                float A = la[it * 64 + lane], C = lc[it * 64 + lane];
                scan_step(A, C, lane);
                const float mt = fmaxf(mcar + A, C);
                const float b = A + ((it & 1) ? bcar : 0.f);
                const size_t r = ((size_t)n * SEQ + it * 64 + lane) * 4 + hh;
                MT[r] = mt; BT[r] = b;
                mcar = __shfl(mt, 63); bcar = __shfl(A, 63);
            }
            if (lane == 0) p.out[O_PM + ch] = mcar;
        }
    }
    if (rb >= 16) {
        for (int sid = (rb - 16) * 8 + wave; sid < 128; sid += (G - 16) * 8) {
            const int n = sid >> 2, hh = sid & 3;
            const size_t r = ((size_t)MP + n * DSEQ + (lane & 31)) * 4 + hh;
            float A = GF[r], C = GI[r];
            const float m0 = PIN(6)[sid];
            scan_step(A, C, lane);
            const float mt = fmaxf(m0 + A, C);
            if (lane < 32) { MT[r] = mt; BT[r] = A; }
            if (lane == 31) p.out[O_SM + sid] = mt;
        }
    }
    __syncthreads();
}
template <int NKT> struct AtPre { u32x4 kr[(NKT * 128 + 511) / 512], vr[(NKT * 128 + 511) / 512]; };
template <int NKT, bool SAMPLE>
DI void attn_load(const Params& p, LAS unsigned char* lds, int r, AtPre<NKT>& R) {
    const int tid = opaque_tid();
    const int n = SAMPLE ? (r >> 1) : (r >> 8), c = SAMPLE ? 0 : ((r >> 1) & 127), kv = r & 1;
    const bf16_t* zKA = (const bf16_t*)(p.ws + WS_ZA + ZA_KA); const bf16_t* zVA = (const bf16_t*)(p.ws + WS_ZA + ZA_VA);
    constexpr int NP = (NKT * 128 + 511) / 512;
#pragma unroll
    for (int i = 0; i < NP; ++i) {
        const int idx = tid + 512 * i; const int row = idx >> 3, ch = idx & 7;
        u32x4 kk = {0u, 0u, 0u, 0u}, vv = kk;
        if (idx < NKT * 128) {
            if (!SAMPLE) {
                const int kpos = (c - 2) * 64 + row;
                if (kpos >= 0) { const size_t o = ((size_t)kv * M + (size_t)n * SEQ + kpos) * 64 + ch * 8; kk = *(const u32x4*)(zKA + o); vv = *(const u32x4*)(zVA + o); }
            } else {
                if (row < 128) {
                    const float* ck = PIN(2) + ((size_t)(n * 128 + row) * 2 + kv) * 64 + ch * 8; const float* cv = PIN(3) + ((size_t)(n * 128 + row) * 2 + kv) * 64 + ch * 8;
                    const f32x4 k0 = *(const f32x4*)ck, k1 = *(const f32x4*)(ck + 4), v0 = *(const f32x4*)cv, v1 = *(const f32x4*)(cv + 4);
                    kk.x = cvtpk(k0[0], k0[1]); kk.y = cvtpk(k0[2], k0[3]); kk.z = cvtpk(k1[0], k1[1]); kk.w = cvtpk(k1[2], k1[3]);
                    vv.x = cvtpk(v0[0], v0[1]); vv.y = cvtpk(v0[2], v0[3]); vv.z = cvtpk(v1[0], v1[1]); vv.w = cvtpk(v1[2], v1[3]);
                } else { const size_t o = ((size_t)kv * M + (size_t)MP + n * DSEQ + row - 128) * 64 + ch * 8; kk = *(const u32x4*)(zKA + o); vv = *(const u32x4*)(zVA + o); }
            }
        }
        R.kr[i] = kk; R.vr[i] = vv;
    }
}
template <int NKT, int NQB, bool SAMPLE>
DI void attn_item(const Params& p, LAS unsigned char* lds, int r, AtPre<NKT>& R, int next_r) {
    const int tid = opaque_tid(), lane = tid & 63, g = __builtin_amdgcn_readfirstlane(tid >> 6), fr = lane & 15, fq = lane >> 4;
    const int n = SAMPLE ? (r >> 1) : (r >> 8), c = SAMPLE ? 0 : ((r >> 1) & 127), kv = r & 1;
    const bf16_t* zA = (const bf16_t*)(p.ws + WS_ZA);
    bf16_t* ya = (bf16_t*)((unsigned char*)p.out + OY_YA);
    LAS unsigned char* Kimg = lds; LAS unsigned char* Vimg = lds + 192 * 144;
    constexpr int NP = (NKT * 128 + 511) / 512;
    __syncthreads();
#pragma unroll
    for (int i = 0; i < NP; ++i) {
        const int idx = tid + 512 * i; const int row = idx >> 3, ch = idx & 7;
        if (idx < NKT * 128) { *(LAS u32x4*)(Kimg + row * 144 + ch * 16) = R.kr[i]; *(LAS u32x4*)(Vimg + row * 144 + ch * 16) = R.vr[i]; }
    }
    __syncthreads();
    if (next_r >= 0) attn_load<NKT, SAMPLE>(p, lds, next_r, R);
    const int hq = kv * 8 + g;
    const float slope2 = exp2f(-0.5f * (float)(hq + 1)) * 1.4426950408889634f, sink2 = PIN(15)[hq] * 1.4426950408889634f;
    constexpr float scale2 = 0.125f * 1.4426950408889634f;
    const size_t rowbase = SAMPLE ? (size_t)MP + n * DSEQ : (size_t)n * SEQ + c * 64;
    const int kmin = SAMPLE ? 0 : (c >= 2 ? 0 : (2 - c) * 64);
    bf16x8 Qf[2];
#pragma unroll
    for (int ks = 0; ks < 2; ++ks) Qf[ks] = ntl((const bf16x8*)(zA + (rowbase + fr) * 1024 + hq * 64 + ks * 32 + fq * 8));
#pragma unroll 1
    for (int qb = 0; qb < NQB; ++qb) {
        const size_t qrow = rowbase + qb * 16 + fr;
        bf16x8 Qn[2];
        { const size_t qnext = qrow + (qb + 1 < NQB ? 16 : 0);
#pragma unroll
          for (int ks = 0; ks < 2; ++ks) Qn[ks] = ntl((const bf16x8*)(zA + qnext * 1024 + hq * 64 + ks * 32 + fq * 8)); }
        f32x4 s[NKT];
#pragma unroll
        for (int kt = 0; kt < NKT; ++kt) {
            s[kt] = (f32x4){0.f, 0.f, 0.f, 0.f};
#pragma unroll
            for (int ks = 0; ks < 2; ++ks) { const bf16x8 A = *(const LAS bf16x8*)(Kimg + (kt * 16 + fr) * 144 + (ks * 32 + fq * 8) * 2); s[kt] = MFMA16(A, Qf[ks], s[kt]); }
        }
        const float fb = (float)(128 + qb * 16 + fr - fq * 4);
#pragma unroll
        for (int kt = 0; kt < NKT; ++kt)
#pragma unroll
            for (int j = 0; j < 4; ++j) { const float t = fb - (float)(kt * 16 + j); s[kt][j] = fmaf(s[kt][j], scale2, -(slope2 * fabsf(t))); }
        if (kmin > 0) {
#pragma unroll
            for (int kt = 0; kt < NKT; ++kt)
#pragma unroll
                for (int j = 0; j < 4; ++j) { const int key = kt * 16 + fq * 4 + j; s[kt][j] = key >= kmin ? s[kt][j] : -1e30f; }
        }
        float mx = sink2;
#pragma unroll
        for (int kt = 0; kt < NKT; ++kt) mx = fmaxf(fmaxf(mx, fmaxf(s[kt][0], s[kt][1])), fmaxf(s[kt][2], s[kt][3]));
        mx = fmaxf(mx, __shfl_xor(mx, 16)); mx = fmaxf(mx, __shfl_xor(mx, 32));
        float sum = 0.f;
#pragma unroll
        for (int kt = 0; kt < NKT; ++kt)
#pragma unroll
            for (int j = 0; j < 4; ++j) { const float e = __builtin_amdgcn_exp2f(s[kt][j] - mx); s[kt][j] = e; sum += e; }
        sum += __shfl_xor(sum, 16); sum += __shfl_xor(sum, 32);
        const float inv = __builtin_amdgcn_rcpf(sum + __builtin_amdgcn_exp2f(sink2 - mx));
        f32x4 o[4];
#pragma unroll
        for (int dt = 0; dt < 4; ++dt) o[dt] = (f32x4){0.f, 0.f, 0.f, 0.f};
#pragma unroll
        for (int kk = 0; kk < NKT / 2; ++kk) {
            u32x4 pw; pw.x = cvtpk(s[2 * kk][0], s[2 * kk][1]); pw.y = cvtpk(s[2 * kk][2], s[2 * kk][3]); pw.z = cvtpk(s[2 * kk + 1][0], s[2 * kk + 1][1]); pw.w = cvtpk(s[2 * kk + 1][2], s[2 * kk + 1][3]);
            const bf16x8 Pf = __builtin_bit_cast(bf16x8, pw);
#pragma unroll
            for (int dt = 0; dt < 4; ++dt) {
                const LAS unsigned char* vp = Vimg + ((2 * kk) * 16 + fq * 4 + (fr >> 2)) * 144 + (dt * 16 + 4 * (fr & 3)) * 2;
                const bf16x8 A = cat8(lds_tr(vp), lds_tr(vp + 16 * 144));
                o[dt] = MFMA16(A, Pf, o[dt]);
            }
        }
#pragma unroll
        for (int dt = 0; dt < 4; dt += 2) { u32x4 w; w.x = cvtpk(o[dt][0] * inv, o[dt][1] * inv); w.y = cvtpk(o[dt][2] * inv, o[dt][3] * inv);
            w.z = cvtpk(o[dt + 1][0] * inv, o[dt + 1][1] * inv); w.w = cvtpk(o[dt + 1][2] * inv, o[dt + 1][3] * inv);
            swap16x2(w);
            *(u32x4*)(ya + qrow * 1024 + hq * 64 + dt * 16 + ((fq & 1) * 16) + ((fq >> 1) * 8)) = w; }
        Qf[0] = Qn[0]; Qf[1] = Qn[1];
    }
}
struct DcPre { u32x4 kr[4], vr[8]; float wkv, Bend, mend; };
template <bool SAMPLE>
DI void dc_load(const Params& p, LAS unsigned char* lds, int r, DcPre& R) {
    const int tid = opaque_tid();
    const int n = SAMPLE ? (r >> 2) : (r >> 8), hh = SAMPLE ? (r & 3) : ((r >> 6) & 3), cc = SAMPLE ? 0 : (r & 63);
    const bf16_t* zB = (const bf16_t*)(p.ws + WS_ZB);
    const float* GI = (const float*)(p.ws + WS_GI); const float* MT = (const float*)(p.ws + WS_MT); const float* BT = (const float*)(p.ws + WS_BT);
    const size_t row0 = SAMPLE ? (size_t)MP + n * DSEQ : (size_t)n * SEQ + cc * 128;
    constexpr int tv = SAMPLE ? DSEQ : 128;
    const size_t rlast = (row0 + tv - 1) * 4 + hh;
    R.Bend = BT[rlast]; R.mend = MT[rlast];
#pragma unroll
    for (int i = 0; i < 4; ++i) { const int idx = tid + 512 * i; const int row = idx >> 4, ch = idx & 15;
        R.kr[i] = (u32x4){0u, 0u, 0u, 0u};
        if (row < tv) R.kr[i] = *(const u32x4*)(zB + ZB_KM / 2 + ((size_t)hh * M + row0 + row) * 128 + ch * 8); }
#pragma unroll
    for (int i = 0; i < 8; ++i) { const int idx = tid + 512 * i; const int row = idx >> 5, ch = idx & 31;
        R.vr[i] = (u32x4){0u, 0u, 0u, 0u};
        if (row < tv) R.vr[i] = *(const u32x4*)(zB + ZB_VM / 2 + ((size_t)hh * M + row0 + row) * 256 + ch * 8); }
    R.wkv = 0.f;
    if (tid < tv) { const size_t rr = (row0 + tid) * 4 + hh; R.wkv = __expf(R.Bend - BT[rr] + GI[rr] - R.mend); }
}
template <bool SAMPLE>
DI void dc_item(const Params& p, LAS unsigned char* lds, int r, DcPre& R, int next_r) {
    constexpr bool sample = SAMPLE;
    const int tid = opaque_tid(), lane = tid & 63, w = __builtin_amdgcn_readfirstlane(tid >> 6), fr = lane & 15, fq = lane >> 4;
    const int n = SAMPLE ? (r >> 2) : (r >> 8), hh = SAMPLE ? (r & 3) : ((r >> 6) & 3), cc = SAMPLE ? 0 : (r & 63);
    LAS unsigned char* KW = lds; LAS unsigned char* Vimg = lds + 128 * 272; LAS float* wk = (LAS float*)(lds + 128 * 272 + 128 * 528);
    constexpr int nks = sample ? 1 : 4;
    const float Bend = R.Bend, mend = R.mend;
    __syncthreads();
    if (tid < 128) wk[tid] = R.wkv;
#pragma unroll
    for (int i = 0; i < 8; ++i) { const int idx = tid + 512 * i; const int row = idx >> 5, ch = idx & 31;
        if (row < nks * 32) *(LAS u32x4*)(Vimg + row * 528 + ch * 16) = R.vr[i]; }
    __syncthreads();
#pragma unroll
    for (int i = 0; i < 4; ++i) { const int idx = tid + 512 * i; const int row = idx >> 4, ch = idx & 15;
        if (row < nks * 32) { const float wv = wk[row]; const u32x4 k = R.kr[i];
            u32x4 o; o.x = cvtpk(bflo(k.x) * wv, bfhi(k.x) * wv); o.y = cvtpk(bflo(k.y) * wv, bfhi(k.y) * wv); o.z = cvtpk(bflo(k.z) * wv, bfhi(k.z) * wv); o.w = cvtpk(bflo(k.w) * wv, bfhi(k.w) * wv);
            *(LAS u32x4*)(KW + row * 272 + ch * 16) = o; } }
    __syncthreads();
    if (next_r >= 0) dc_load<SAMPLE>(p, lds, next_r, R);
    f32x4 acc[8][2];
#pragma unroll
    for (int mt = 0; mt < 8; ++mt) { acc[mt][0] = (f32x4){0.f, 0.f, 0.f, 0.f}; acc[mt][1] = acc[mt][0]; }
    for (int ks = 0; ks < nks; ++ks) {
        const int lrow = ks * 32 + fq * 8 + (fr >> 2);
        bf16x8 Bf[2];
#pragma unroll
        for (int nt = 0; nt < 2; ++nt) { const LAS unsigned char* vp = Vimg + lrow * 528 + ((2 * w + nt) * 16 + 4 * (fr & 3)) * 2; Bf[nt] = cat8(lds_tr(vp), lds_tr(vp + 4 * 528)); }
#pragma unroll
        for (int mt = 0; mt < 8; ++mt) {
            const LAS unsigned char* kp = KW + lrow * 272 + (mt * 16 + 4 * (fr & 3)) * 2;
            const bf16x8 Af = cat8(lds_tr(kp), lds_tr(kp + 4 * 272));
            acc[mt][0] = MFMA16(Af, Bf[0], acc[mt][0]); acc[mt][1] = MFMA16(Af, Bf[1], acc[mt][1]);
        }
    }
    const int chain = n * 4 + hh;
    if (!sample) {
        bf16_t* CS = (bf16_t*)(p.ws + WS_CS) + ((size_t)(chain * 64 + cc)) * 32768;
        const int wide = ((fq & 1) * 16) + ((fq >> 1) * 8);
#pragma unroll
        for (int mt = 0; mt < 8; mt += 2)
#pragma unroll
            for (int nt = 0; nt < 2; ++nt) { const int dv = (2 * w + nt) * 16 + fr;
                u32x4 o; o.x = cvtpk(acc[mt][nt][0], acc[mt][nt][1]); o.y = cvtpk(acc[mt][nt][2], acc[mt][nt][3]);
                o.z = cvtpk(acc[mt + 1][nt][0], acc[mt + 1][nt][1]); o.w = cvtpk(acc[mt + 1][nt][2], acc[mt + 1][nt][3]);
                swap16x2(o);
                *(u32x4*)(CS + dv * 128 + mt * 16 + wide) = o; }
        if (tid < 128) { float s = 0.f; for (int l = 0; l < 128; ++l) s += __uint_as_float((unsigned)(*(const LAS unsigned short*)(KW + l * 272 + tid * 2)) << 16);
            ((float*)(p.ws + WS_CSN))[(size_t)(chain * 64 + cc) * 128 + tid] = s; }
    } else {
        const float decay = __expf(Bend + PIN(6)[chain] - mend);
        const float* C0 = PIN(4) + (size_t)chain * 32768; float* Co = p.out + O_SC + (size_t)chain * 32768;
#pragma unroll
        for (int mt = 0; mt < 8; ++mt)
#pragma unroll
            for (int nt = 0; nt < 2; ++nt) { const int dv = (2 * w + nt) * 16 + fr, dq = mt * 16 + fq * 4;
                const f32x4 c0 = *(const f32x4*)(C0 + dv * 128 + dq);
                *(f32x4*)(Co + dv * 128 + dq) = c0 * decay + acc[mt][nt]; }
        if (tid < 128) { float s = 0.f; for (int l = 0; l < DSEQ; ++l) s += __uint_as_float((unsigned)(*(const LAS unsigned short*)(KW + l * 272 + tid * 2)) << 16);
            p.out[O_SN + (size_t)chain * 128 + tid] = decay * PIN(5)[(size_t)chain * 128 + tid] + s; }
    }
}
DI void phase2_dc(const Params& p, LAS unsigned char* lds) {
    const int G = gridDim.x, b0 = blockIdx.x;
    DcPre R;
    { int r = b0; if (r < 1024) dc_load<false>(p, lds, r, R);
      for (; r < 1024; r += G) { const int nx = r + G; dc_item<false>(p, lds, r, R, nx < 1024 ? nx : -1); } }
    { int r = b0; if (r < 128) dc_load<true>(p, lds, r, R);
      for (; r < 128; r += G) { const int nx = r + G; dc_item<true>(p, lds, r, R, nx < 128 ? nx : -1); } }
}
DI void phase2_at(const Params& p, LAS unsigned char* lds) {
    const int G = gridDim.x, b0 = blockIdx.x;
    { AtPre<12> R; int r = b0; if (r < 1024) attn_load<12, false>(p, lds, r, R);
      for (; r < 1024; r += G) { const int nx = r + G; attn_item<12, 4, false>(p, lds, r, R, nx < 1024 ? nx : -1); } }
    { AtPre<10> R; int r = G - 1 - b0;
      if (r < 64) attn_load<10, true>(p, lds, r, R);
      for (; r < 64; r += G) { const int nx = r + G; attn_item<10, 2, true>(p, lds, r, R, nx < 64 ? nx : -1); } }
}
DI void phase2(const Params& p, LAS unsigned char* lds) {
    if (((blockIdx.x >> 3) & 1) == 0) { phase2_dc(p, lds); phase2_at(p, lds); }
    else { phase2_at(p, lds); phase2_dc(p, lds); }
}
DI void phase3(const Params& p, LAS unsigned char* lds) {
    const int tid = opaque_tid();
    LAS float* dec = (LAS float*)lds;
    const float* MT = (const float*)(p.ws + WS_MT); const float* BT = (const float*)(p.ws + WS_BT);
    for (int g0 = blockIdx.x * 256; g0 < 16 * 4096; g0 += gridDim.x * 256) {
        const int chain = g0 >> 12, n = chain >> 2, hh = chain & 3;
        __syncthreads();
        if (tid < 64) { const size_t rl = ((size_t)n * SEQ + tid * 128 + 127) * 4 + hh;
            const float mprev = tid > 0 ? MT[rl - 512] : 0.f; dec[tid] = __expf(BT[rl] + mprev - MT[rl]); }
        __syncthreads();
        if (tid < 256) {
            const int e8 = (g0 + tid) & 4095;
            bf16_t* ptr = (bf16_t*)(p.ws + WS_CS) + (size_t)chain * 64 * 32768 + e8 * 8;
            f32x4 ra = {0.f, 0.f, 0.f, 0.f}, rb = ra;
#pragma unroll 8
            for (int c = 0; c < 64; ++c) {
                const u32x4 d = *(const u32x4*)(ptr + (size_t)c * 32768);
                u32x4 o; o.x = cvtpk(ra[0], ra[1]); o.y = cvtpk(ra[2], ra[3]); o.z = cvtpk(rb[0], rb[1]); o.w = cvtpk(rb[2], rb[3]);
                *(u32x4*)(ptr + (size_t)c * 32768) = o;
                const float dc = dec[c];
                ra[0] = ra[0] * dc + bflo(d.x); ra[1] = ra[1] * dc + bfhi(d.x); ra[2] = ra[2] * dc + bflo(d.y); ra[3] = ra[3] * dc + bfhi(d.y);
                rb[0] = rb[0] * dc + bflo(d.z); rb[1] = rb[1] * dc + bfhi(d.z); rb[2] = rb[2] * dc + bflo(d.w); rb[3] = rb[3] * dc + bfhi(d.w);
            }
            float* op = p.out + O_PC + (size_t)chain * 32768 + e8 * 8;
            *(f32x4*)op = ra; *(f32x4*)(op + 4) = rb;
            if (e8 < 128) {
                float* np = (float*)(p.ws + WS_CSN) + (size_t)chain * 64 * 128 + e8; float rn = 0.f;
                for (int c = 0; c < 64; ++c) { const float d = np[c * 128]; np[c * 128] = rn; rn = rn * dec[c] + d; }
                p.out[O_PN + chain * 128 + e8] = rn;
            }
        }
    }
}
struct MoutPre { u32x4 qr[4], kr[4], cr[8]; float nvv, biv, mstart, bl, mtl; };
template <bool SAMPLE>
DI void mout_load(const Params& p, LAS unsigned char* lds, int it, MoutPre& R) {
    const int tid = opaque_tid(), lane = tid & 63, w = __builtin_amdgcn_readfirstlane(tid >> 6), fr = lane & 15;
    constexpr bool sample = SAMPLE;
    const int r_ = it - 1024;
    const int n = sample ? (r_ >> 2) : (it >> 8), hh = sample ? (r_ & 3) : ((it >> 6) & 3), cc = sample ? 0 : (it & 63);
    const bf16_t* zB = (const bf16_t*)(p.ws + WS_ZB);
    const float* GI = (const float*)(p.ws + WS_GI); const float* MT = (const float*)(p.ws + WS_MT); const float* BT = (const float*)(p.ws + WS_BT);
    const size_t row0 = sample ? (size_t)MP + n * DSEQ : (size_t)n * SEQ + cc * 128;
    constexpr int tv = sample ? DSEQ : 128;
    const int chain = n * 4 + hh;
#pragma unroll
    for (int i = 0; i < 4; ++i) { const int idx = tid + 512 * i; const int row = idx >> 4, ch = idx & 15;
        R.qr[i] = (u32x4){0u, 0u, 0u, 0u}; R.kr[i] = R.qr[i];
        if (row < tv) { const bf16_t* src = zB + ((size_t)hh * M + row0 + row) * 128 + ch * 8; R.qr[i] = ntl((const u32x4*)src); R.kr[i] = ntl((const u32x4*)(src + ZB_KM / 2)); } }
    if (!sample) {
        const bf16_t* CS = (const bf16_t*)(p.ws + WS_CS) + ((size_t)(chain * 64 + cc)) * 32768;
#pragma unroll
        for (int i = 0; i < 8; ++i) { const int idx = tid + 512 * i; const int row = idx >> 4, ch = idx & 15; R.cr[i] = ntl((const u32x4*)(CS + row * 128 + ch * 8)); }
    } else {
        const float* C0 = PIN(4) + (size_t)chain * 32768;
#pragma unroll
        for (int i = 0; i < 8; ++i) { const int idx = tid + 512 * i; const int row = idx >> 4, ch = idx & 15;
            const f32x4 a = *(const f32x4*)(C0 + row * 128 + ch * 8), b = *(const f32x4*)(C0 + row * 128 + ch * 8 + 4);
            u32x4 o; o.x = cvtpk(a[0], a[1]); o.y = cvtpk(a[2], a[3]); o.z = cvtpk(b[0], b[1]); o.w = cvtpk(b[2], b[3]); R.cr[i] = o; }
    }
    R.nvv = 0.f; R.biv = 0.f;
    if (tid < 128) {
        R.nvv = sample ? PIN(5)[(size_t)chain * 128 + tid] : ((const float*)(p.ws + WS_CSN))[(size_t)(chain * 64 + cc) * 128 + tid];
        if (tid < tv) { const size_t r = (row0 + tid) * 4 + hh; R.biv = GI[r] - BT[r]; }
    }
    R.mstart = sample ? PIN(6)[chain] : (cc > 0 ? MT[(row0 - 1) * 4 + hh] : 0.f);
    const size_t row = row0 + w * 16 + fr;
    R.bl = 0.f; R.mtl = 0.f;
    if (w * 16 < tv) { R.bl = BT[row * 4 + hh]; R.mtl = MT[row * 4 + hh]; }
}
template <bool SAMPLE>
DI void mout_item(const Params& p, LAS unsigned char* lds, int it, MoutPre& R, int next_it) {
    const int tid = opaque_tid(), lane = tid & 63, w = __builtin_amdgcn_readfirstlane(tid >> 6), fr = lane & 15, fq = lane >> 4;
    constexpr bool sample = SAMPLE;
    const int r_ = it - 1024;
    const int n = sample ? (r_ >> 2) : (it >> 8), hh = sample ? (r_ & 3) : ((it >> 6) & 3), cc = sample ? 0 : (it & 63);
    const bf16_t* zB = (const bf16_t*)(p.ws + WS_ZB); const bf16_t* zG = (const bf16_t*)(p.ws + WS_ZG);
    bf16_t* yb = (bf16_t*)((unsigned char*)p.out + OY_YB);
    LAS unsigned char* Qimg = lds; LAS unsigned char* Kimg = lds + 34816; LAS unsigned char* CV = lds + 69632;
    LAS float* bi = (LAS float*)(lds + 139264); LAS float* nv = bi + 128; LAS float* nwl = bi + 256;
    const size_t row0 = sample ? (size_t)MP + n * DSEQ : (size_t)n * SEQ + cc * 128;
    constexpr int tv = sample ? DSEQ : 128;
    const bool active = w * 16 < tv;
    const size_t row = row0 + w * 16 + fr;
    const float mstart = R.mstart, bl = R.bl, mtl = R.mtl;
    __syncthreads();
#pragma unroll
    for (int i = 0; i < 4; ++i) { const int idx = tid + 512 * i; const int r = idx >> 4, ch = idx & 15;
        *(LAS u32x4*)(Qimg + r * 272 + ch * 16) = R.qr[i]; *(LAS u32x4*)(Kimg + r * 272 + ch * 16) = R.kr[i]; }
#pragma unroll
    for (int i = 0; i < 8; ++i) { const int idx = tid + 512 * i; const int r = idx >> 4, ch = idx & 15; *(LAS u32x4*)(CV + r * 272 + ch * 16) = R.cr[i]; }
    if (tid < 128) { nv[tid] = R.nvv; bi[tid] = R.biv; }
    if (tid >= 256) nwl[tid - 256] = PIN(16)[hh * 256 + tid - 256];
    u32x4 vr[8];
#pragma unroll
    for (int i = 0; i < 8; ++i) { const int idx = tid + 512 * i; const int r = idx >> 5, ch = idx & 31;
        vr[i] = (u32x4){0u, 0u, 0u, 0u};
        if (r < tv) vr[i] = ntl((const u32x4*)(zB + ZB_VM / 2 + ((size_t)hh * M + row0 + r) * 256 + ch * 8)); }
    __syncthreads();
    f32x4 acc[16];
    bf16x8 Pf[4];
    float den = 0.f;
    if (active) {
        const float gsc = __expf(bl + mstart - mtl);
        bf16x8 Qf[4];
#pragma unroll
        for (int ks = 0; ks < 4; ++ks) Qf[ks] = *(const LAS bf16x8*)(Qimg + (w * 16 + fr) * 272 + (ks * 32 + fq * 8) * 2);
        float qn = 0.f;
#pragma unroll
        for (int ks = 0; ks < 4; ++ks) {
            const f32x4 n0 = *(const LAS f32x4*)(nv + ks * 32 + fq * 8), n1 = *(const LAS f32x4*)(nv + ks * 32 + fq * 8 + 4);
            const u32x4 qq = __builtin_bit_cast(u32x4, Qf[ks]);
            qn += bflo(qq.x) * n0[0] + bfhi(qq.x) * n0[1] + bflo(qq.y) * n0[2] + bfhi(qq.y) * n0[3] + bflo(qq.z) * n1[0] + bfhi(qq.z) * n1[1] + bflo(qq.w) * n1[2] + bfhi(qq.w) * n1[3];
        }
        qn += __shfl_xor(qn, 16); qn += __shfl_xor(qn, 32);
        den = gsc * qn;
        f32x4 s[8];
        float dsum = 0.f;
        const float blm = bl - mtl;
        const int lidx = w * 16 + fr;
#pragma unroll
        for (int kt = 0; kt < 8; ++kt) {
            s[kt] = (f32x4){0.f, 0.f, 0.f, 0.f};
            if (kt <= w) {
#pragma unroll
                for (int ks = 0; ks < 4; ++ks) { const bf16x8 A = *(const LAS bf16x8*)(Kimg + (kt * 16 + fr) * 272 + (ks * 32 + fq * 8) * 2); s[kt] = MFMA16(A, Qf[ks], s[kt]); }
                const f32x4 bv = *(const LAS f32x4*)(bi + kt * 16 + fq * 4);
#pragma unroll
                for (int j = 0; j < 4; ++j) { const int key = kt * 16 + fq * 4 + j; const float pv = key <= lidx ? s[kt][j] * __expf(blm + bv[j]) : 0.f; s[kt][j] = pv; dsum += pv; }
            }
        }
        dsum += __shfl_xor(dsum, 16); dsum += __shfl_xor(dsum, 32);
        den += dsum;
#pragma unroll
        for (int kk = 0; kk < 4; ++kk) { u32x4 pw; pw.x = cvtpk(s[2 * kk][0], s[2 * kk][1]); pw.y = cvtpk(s[2 * kk][2], s[2 * kk][3]); pw.z = cvtpk(s[2 * kk + 1][0], s[2 * kk + 1][1]); pw.w = cvtpk(s[2 * kk + 1][2], s[2 * kk + 1][3]);
            Pf[kk] = __builtin_bit_cast(bf16x8, pw); }
#pragma unroll
        for (int mt = 0; mt < 16; ++mt) {
            acc[mt] = (f32x4){0.f, 0.f, 0.f, 0.f};
#pragma unroll
            for (int ks = 0; ks < 4; ++ks) { const bf16x8 A = *(const LAS bf16x8*)(CV + (mt * 16 + fr) * 272 + (ks * 32 + fq * 8) * 2); acc[mt] = MFMA16(A, Qf[ks], acc[mt]); }
            acc[mt] = acc[mt] * gsc;
            if (mt & 1) __builtin_amdgcn_sched_barrier(0);
        }
    }
    __syncthreads();
#pragma unroll
    for (int i = 0; i < 8; ++i) { const int idx = tid + 512 * i; const int r = idx >> 5, ch = idx & 31; *(LAS u32x4*)(CV + r * 528 + ch * 16) = vr[i]; }
    __syncthreads();
    if (next_it >= 0) mout_load<SAMPLE>(p, lds, next_it, R);
    if (active) {
#pragma unroll
        for (int mt = 0; mt < 16; ++mt)
#pragma unroll
            for (int kk = 0; kk < 4; ++kk)
                if (2 * kk <= w) {
                    const LAS unsigned char* vp = CV + ((2 * kk) * 16 + fq * 4 + (fr >> 2)) * 528 + (mt * 16 + 4 * (fr & 3)) * 2;
                    const bf16x8 A = cat8(lds_tr(vp), lds_tr(vp + 16 * 528));
                    acc[mt] = MFMA16(A, Pf[kk], acc[mt]);
                    if (kk == 3) __builtin_amdgcn_sched_barrier(0);
                }
        const float inv = 1.f / fmaxf(fabsf(den), __expf(-mtl));
        float sm = 0.f;
#pragma unroll
        for (int mt = 0; mt < 16; ++mt) { acc[mt] = acc[mt] * inv; sm += (acc[mt][0] + acc[mt][1]) + (acc[mt][2] + acc[mt][3]); }
        sm += __shfl_xor(sm, 16); sm += __shfl_xor(sm, 32);
        const float mean = sm * (1.f / 256.f);
        float sv = 0.f;
#pragma unroll
        for (int mt = 0; mt < 16; ++mt) { acc[mt] = acc[mt] - mean; sv += (acc[mt][0] * acc[mt][0] + acc[mt][1] * acc[mt][1]) + (acc[mt][2] * acc[mt][2] + acc[mt][3] * acc[mt][3]); }
        sv += __shfl_xor(sv, 16); sv += __shfl_xor(sv, 32);
        const float rstd = 1.f / sqrtf(sv * (1.f / 256.f) + LN_EPS);
        const float* nw = PIN(16) + hh * 256;
        const int wide = ((fq & 1) * 16) + ((fq >> 1) * 8);
#pragma unroll
        for (int mt = 0; mt < 16; mt += 2) {
            const int dv = mt * 16 + fq * 4;
            const f32x4 wa = *(const LAS f32x4*)(nwl + dv), wb = *(const LAS f32x4*)(nwl + dv + 16);
            u32x4 og = ntl((const u32x4*)(zG + ((size_t)hh * M + row) * 256 + mt * 16 + wide));
            swap16x2(og);
            u32x4 o;
            o.x = cvtpk(acc[mt][0] * rstd * wa[0] * bflo(og.x), acc[mt][1] * rstd * wa[1] * bfhi(og.x));
            o.y = cvtpk(acc[mt][2] * rstd * wa[2] * bflo(og.y), acc[mt][3] * rstd * wa[3] * bfhi(og.y));
            o.z = cvtpk(acc[mt + 1][0] * rstd * wb[0] * bflo(og.z), acc[mt + 1][1] * rstd * wb[1] * bfhi(og.z));
            o.w = cvtpk(acc[mt + 1][2] * rstd * wb[2] * bflo(og.w), acc[mt + 1][3] * rstd * wb[3] * bfhi(og.w));
            swap16x2(o);
            *(u32x4*)(yb + row * 1024 + hh * 256 + mt * 16 + wide) = o;
        }
    }
}
DI void phase4(const Params& p, LAS unsigned char* lds) {
    const int G = gridDim.x;
    MoutPre R;
    { int it = blockIdx.x;
      if (it < 1024) mout_load<false>(p, lds, it, R);
      for (; it < 1024; it += G) { const int nx = it + G; mout_item<false>(p, lds, it, R, nx < 1024 ? nx : -1); } }
    { int it = 1024 + blockIdx.x;
      if (it < 1152) mout_load<true>(p, lds, it, R);
      for (; it < 1152; it += G) { const int nx = it + G; mout_item<true>(p, lds, it, R, nx < 1152 ? nx : -1); } }
}
template <bool FIRST>
DI void ln_rows(const Params& p, LAS unsigned char* lds) {
    const int tid = opaque_tid(), lane = tid & 63, wave = tid >> 6;
    const bf16_t* rbuf = (const bf16_t*)(p.ws + (FIRST ? WS_R1 : WS_R2));
    const float* lw = FIRST ? PIN(20) : PIN(27); const float* lb = FIRST ? PIN(21) : PIN(28);
    const float* mod = (const float*)(p.ws + WS_MOD);
    bf16_t* h2 = (bf16_t*)((unsigned char*)p.out + OY_H2);
    bf16_t* x1h = (bf16_t*)(p.ws + WS_X1);
    const float* xp0 = PIN(0); const float* xs0 = PIN(1);
    for (int rg = blockIdx.x * 8 + wave; rg < M / 4; rg += gridDim.x * 8) {
        f32x4 v[4][4]; float s[4], s2[4];
#pragma unroll
        for (int q = 0; q < 4; ++q) { const int rr = rg * 4 + q; const bf16_t* rp = rbuf + (size_t)rr * D; s[q] = 0.f;
#pragma unroll
            for (int i = 0; i < 2; ++i) { const int c = 8 * lane + 512 * i;
                const u32x4 rv = ntl((const u32x4*)(rp + c));
                const f32x4 ra = {bflo(rv.x), bfhi(rv.x), bflo(rv.y), bfhi(rv.y)}, rb = {bflo(rv.z), bfhi(rv.z), bflo(rv.w), bfhi(rv.w)};
                f32x4 xa, xb;
                if (FIRST) { const float* xr = xrow_of(xp0, xs0, rr) + c; xa = ntl((const f32x4*)xr); xb = ntl((const f32x4*)(xr + 4)); }
                else { const u32x4 xv = ntl((const u32x4*)(x1h + (size_t)rr * D + c)); xa = (f32x4){bflo(xv.x), bfhi(xv.x), bflo(xv.y), bfhi(xv.y)}; xb = (f32x4){bflo(xv.z), bfhi(xv.z), bflo(xv.w), bfhi(xv.w)}; }
                v[q][2 * i] = ra + xa * ALPHA; v[q][2 * i + 1] = rb + xb * ALPHA;
                s[q] += ((v[q][2 * i][0] + v[q][2 * i][1]) + (v[q][2 * i][2] + v[q][2 * i][3])) + ((v[q][2 * i + 1][0] + v[q][2 * i + 1][1]) + (v[q][2 * i + 1][2] + v[q][2 * i + 1][3])); } }
#pragma unroll
        for (int q = 0; q < 4; ++q) s[q] = wave_sum(s[q]) * (1.f / D);
#pragma unroll
        for (int q = 0; q < 4; ++q) { s2[q] = 0.f;
#pragma unroll
            for (int i = 0; i < 4; ++i) { v[q][i] = v[q][i] - s[q]; s2[q] += (v[q][i][0] * v[q][i][0] + v[q][i][1] * v[q][i][1]) + (v[q][i][2] * v[q][i][2] + v[q][i][3] * v[q][i][3]); } }
#pragma unroll
        for (int q = 0; q < 4; ++q) s2[q] = 1.f / sqrtf(wave_sum(s2[q]) * (1.f / D) + LN_EPS);
#pragma unroll
        for (int q = 0; q < 4; ++q) {
            const int row = rg * 4 + q;
            const float* mr = mod + (size_t)crow_of(row) * 6144;
#pragma unroll
            for (int i = 0; i < 2; ++i) {
                const int c = 8 * lane + 512 * i;
                const f32x4 ya = v[q][2 * i] * s2[q] * *(const f32x4*)(lw + c) + *(const f32x4*)(lb + c);
                const f32x4 yb = v[q][2 * i + 1] * s2[q] * *(const f32x4*)(lw + c + 4) + *(const f32x4*)(lb + c + 4);
                if (FIRST) {
                    u32x4 xw; xw.x = cvtpk(ya[0], ya[1]); xw.y = cvtpk(ya[2], ya[3]); xw.z = cvtpk(yb[0], yb[1]); xw.w = cvtpk(yb[2], yb[3]);
                    *(u32x4*)(x1h + (size_t)row * D + c) = xw;
                    const f32x4 ha = ya * (*(const f32x4*)(mr + 4096 + c) + 1.f) + *(const f32x4*)(mr + 3072 + c);
                    const f32x4 hb = yb * (*(const f32x4*)(mr + 4096 + c + 4) + 1.f) + *(const f32x4*)(mr + 3072 + c + 4);
                    u32x4 w; w.x = cvtpk(ha[0], ha[1]); w.y = cvtpk(ha[2], ha[3]); w.z = cvtpk(hb[0], hb[1]); w.w = cvtpk(hb[2], hb[3]);
                    *(u32x4*)(h2 + (size_t)row * D + c) = w;
                } else { float* yp = p.out + O_Y + (size_t)row * D + c; nts((f32x4*)yp, ya); nts((f32x4*)(yp + 4), yb); }
            }
        }
    }
}
DI void phase7(const Params& p, LAS unsigned char* lds) {
    const int tid = opaque_tid(), lane = tid & 63, wave = tid >> 6;
    LAS float* scr = (LAS float*)(lds + wave * 8448);
    constexpr int I_UP = 16 * 176, I_DN = 44 * 32;
    const float* w_up = PIN(22); const float* w_dn = PIN(26);
    for (int it = blockIdx.x * 8 + wave; it < I_UP + I_DN; it += gridDim.x * 8) {
        if (it < I_UP) { const int kb = it / 176, nb = it - kb * 176; const int n0 = nb * 32; const int pn = n0 >> 8, wi = n0 & 255;
            wtrans_item(w_up, DFF2, kb * 64, (wi >> 7) * DFF + pn * 128 + (wi & 127), (bf16_t*)(p.ws + WS_WUP), D, n0, scr, lane); }
        else { const int r = it - I_UP; wtrans_item(w_dn, D, (r >> 5) * 64, (r & 31) * 32, (bf16_t*)(p.ws + WS_WD), DFF, (r & 31) * 32, scr, lane); }
    }
    ln_rows<true>(p, lds);
}


template <int MODE, int KK>
DI void small_gemm(const Params& p, LAS unsigned char* lds, const bf16_t* A, const bf16_t* Bt) {
    const int tid = opaque_tid(), lane = tid & 63, w = __builtin_amdgcn_readfirstlane(tid >> 6), fr = lane & 15, fq = lane >> 4;
    constexpr int KS = KK / 8 / 32;
    LAS f32x4* red = (LAS f32x4*)lds;
    for (int t = blockIdx.x; t < 256; t += gridDim.x) {
        const int row0 = MP + (t >> 4) * 64, col0 = (t & 15) * 64;
        const bf16_t* ap = A + (size_t)(row0 + fr) * KK + w * (KK / 8) + fq * 8;
        const bf16_t* bp = Bt + (size_t)(col0 + fr) * KK + w * (KK / 8) + fq * 8;
        f32x4 acc[4][4];
#pragma unroll
        for (int i = 0; i < 4; ++i)
#pragma unroll
            for (int j = 0; j < 4; ++j) acc[i][j] = (f32x4){0.f, 0.f, 0.f, 0.f};
#pragma unroll
        for (int k0 = 0; k0 < KS; k0 += 4) {
            bf16x8 af[4][4], bf[4][4];
#pragma unroll
            for (int kk = 0; kk < 4; ++kk)
                if (k0 + kk < KS) {
#pragma unroll
                    for (int i = 0; i < 4; ++i) { af[kk][i] = *(const bf16x8*)(ap + (size_t)(i * 16) * KK + (k0 + kk) * 32); bf[kk][i] = *(const bf16x8*)(bp + (size_t)(i * 16) * KK + (k0 + kk) * 32); }
                }
            __builtin_amdgcn_sched_barrier(0);
#pragma unroll
            for (int kk = 0; kk < 4; ++kk)
                if (k0 + kk < KS) {
#pragma unroll
                    for (int i = 0; i < 4; ++i)
#pragma unroll
                        for (int j = 0; j < 4; ++j) acc[i][j] = MFMA16(af[kk][i], bf[kk][j], acc[i][j]);
                }
        }
        __syncthreads();
#pragma unroll
        for (int i = 0; i < 4; ++i)
#pragma unroll
            for (int j = 0; j < 4; ++j) red[(w * 16 + i * 4 + j) * 64 + lane] = acc[i][j];
        __syncthreads();
#pragma unroll
        for (int q = 0; q < 2; ++q) {
            const int tl = 2 * w + q, rt = tl >> 2, ct = tl & 3;
            f32x4 sum = red[tl * 64 + lane];
#pragma unroll
            for (int ww = 1; ww < 8; ++ww) sum = sum + red[(ww * 16 + tl) * 64 + lane];
            const int col = col0 + ct * 16 + fr;
#pragma unroll
            for (int j = 0; j < 4; ++j) {
                const int row = row0 + rt * 16 + fq * 4 + j;
                float v = sum[j];
                if (MODE < 2) {
                    const bf16_t* zG = (const bf16_t*)(p.ws + WS_ZG + ZG_GAB); bf16_t* MG = (bf16_t*)(p.ws + WS_MG);
                    v *= __uint_as_float((unsigned)zG[(size_t)row * 2048 + MODE * 1024 + col] << 16);
                    if (MODE == 1) v += __uint_as_float((unsigned)MG[(size_t)row * 1024 + col] << 16);
                    MG[(size_t)row * 1024 + col] = (bf16_t)(cvtpk(v, 0.f) & 0xffffu);
                } else {
                    bf16_t* dst = (bf16_t*)(p.ws + (MODE == 2 ? WS_R1 : WS_R2));
                    const float g = ((const float*)(p.ws + WS_MOD))[(size_t)crow_of(row) * 6144 + (MODE == 2 ? 2048 : 5120) + col];
                    dst[(size_t)row * D + col] = (bf16_t)(cvtpk(v * g, 0.f) & 0xffffu);
                }
            }
        }
        __syncthreads();
    }
}

#define XB_TMO      128
#define XB_XCNT(j)  (256  + 64 * (j))
#define XB_XSUB(j)  (1280 + 64 * (j))
#define XB_XGEN(j)  (2304 + 64 * (j))
#define XB_TOP      3328
#define XB_TOPGEN   3392
#define XCD_BAR_WORDS 3456
#define XB_SPIN_CAP (1u << 18)
DI unsigned xb_ld(unsigned* p)              { return __hip_atomic_load(p, __ATOMIC_RELAXED, __HIP_MEMORY_SCOPE_AGENT); }
DI unsigned xb_add(unsigned* p, unsigned v) { return __hip_atomic_fetch_add(p, v, __ATOMIC_RELAXED, __HIP_MEMORY_SCOPE_AGENT); }
DI unsigned xb_xcc_id() { return (unsigned)__builtin_amdgcn_s_getreg((3 << 11) | 20) & 0xFu; }
#define XB_SPIN(cond, bar) do { unsigned _sp = 0; while (cond) { __builtin_amdgcn_s_sleep(1); \
    if ((++_sp & 255u) == 0u) { if (xb_ld(&(bar)[XB_TMO])) break; if (_sp > XB_SPIN_CAP) { atomicAdd(&(bar)[XB_TMO], 1u); break; } } } } while (0)
struct XcdBarrier { unsigned* bar; unsigned x; volatile LAS unsigned* st; };
DI XcdBarrier xcd_barrier_post(unsigned* bar, volatile LAS unsigned* st) {
    XcdBarrier b; b.bar = bar; b.x = xb_xcc_id(); b.st = st;
    if (threadIdx.x == 0) (void)xb_add(&bar[XB_XCNT(b.x)], 1u);
    return b;
}
DI void xcd_barrier_complete(unsigned* bar, unsigned x, unsigned& nloc, unsigned& nx) {
    const unsigned G = gridDim.x * gridDim.y * gridDim.z;
    unsigned sum, cnt, mine, sp = 0u;
    for (;;) {
        sum = 0u; cnt = 0u; mine = 0u;
#pragma unroll
        for (unsigned j = 0; j < 16; ++j) { const unsigned c = xb_ld(&bar[XB_XCNT(j)]); sum += c; cnt += (c > 0u) ? 1u : 0u; mine = (j == x) ? c : mine; }
        if (sum == G) break;
        __builtin_amdgcn_s_sleep(1);
        if ((++sp & 255u) == 0u) { if (xb_ld(&bar[XB_TMO])) break; if (sp > XB_SPIN_CAP) { atomicAdd(&bar[XB_TMO], 1u); break; } }
    }
    nloc = mine > 0u ? mine : 1u; nx = cnt > 0u ? cnt : 1u;
}
DI void xcd_barrier(const XcdBarrier& b) {
    asm volatile("s_waitcnt vmcnt(0)" ::: "memory");
    __syncthreads();
    if (threadIdx.x == 0) {
        unsigned* bar = b.bar;
        __builtin_amdgcn_s_waitcnt(0);
        unsigned nloc = b.st[0], nx = b.st[1];
        if (nloc == 0u) { xcd_barrier_complete(bar, b.x, nloc, nx); b.st[0] = nloc; b.st[1] = nx; }
        const unsigned old = xb_add(&bar[XB_XSUB(b.x)], 1u);
        const unsigned gen = old / nloc;
        if (old + 1u == (gen + 1u) * nloc) {
            __builtin_amdgcn_fence(__ATOMIC_RELEASE, "agent");
            asm volatile("s_waitcnt vmcnt(0)" ::: "memory");
            const unsigned og = xb_add(&bar[XB_TOP], 1u);
            const unsigned tg = og / nx;
            if (og + 1u == (tg + 1u) * nx) xb_add(&bar[XB_TOPGEN], 1u);
            else XB_SPIN(xb_ld(&bar[XB_TOPGEN]) == tg, bar);
            __builtin_amdgcn_fence(__ATOMIC_ACQUIRE, "agent");
            xb_add(&bar[XB_XGEN(b.x)], 1u);
            asm volatile("s_waitcnt vmcnt(0)" ::: "memory");
        } else {
            XB_SPIN(xb_ld(&bar[XB_XGEN(b.x)]) == gen, bar);
            __builtin_amdgcn_fence(__ATOMIC_ACQUIRE, "agent");
            asm volatile("s_waitcnt vmcnt(0)" ::: "memory");
        }
    }
    __syncthreads();
}
constexpr int LDS_XBST = 146688;
constexpr size_t WS_BAR = WS_END;
static_assert(WS_BAR + XCD_BAR_WORDS * 4 <= 536870912, "ws bar");

template <int LO, int HI>
__global__ void __launch_bounds__(512) mk_fwd(Params p) {
    extern __shared__ __attribute__((aligned(16))) unsigned char smem[];
    LAS unsigned char* lds = (LAS unsigned char*)smem;
    cg::grid_group grid = cg::this_grid();
    {
#pragma unroll
        for (int i = 0; i < 29; ++i) if (threadIdx.x == i) *(LAS unsigned long long*)(lds + LDS_TAB + 8 * i) = (unsigned long long)p.in[i];
    }
    if (threadIdx.x < 2) ((volatile LAS unsigned*)(lds + LDS_XBST))[threadIdx.x] = 0u;
    __syncthreads();
    constexpr int lo = LO, hi = HI;
    if (p.ph_lo < 0) grid.sync();
    XcdBarrier xbar; xbar.bar = (unsigned*)(p.ws + WS_BAR); xbar.x = 0; xbar.st = (volatile LAS unsigned*)(lds + LDS_XBST);
    if (HI - LO > 1) xbar = xcd_barrier_post((unsigned*)(p.ws + WS_BAR), (volatile LAS unsigned*)(lds + LDS_XBST));
#ifndef PROBE_MASK
#define PROBE_MASK 0
#endif
#define REPS(k) (1 + ((PROBE_MASK >> (k)) & 1))
#define IN(k) (lo <= (k) && (k) < hi)
#define SEAM(k) do { if (IN(k) && IN((k) + 1)) xcd_barrier(xbar); } while (0)
    if (IN(0)) { phase0a(p, lds);
    }
    SEAM(0);
    if (IN(1)) { phase0b(p, lds);
    }
    SEAM(1);
    if (IN(2)) {
        mscan(p, lds);
        EpiWin E{p.ws, p.out};
        pg8::gemm_phase<EpiWin, true, 132, 25, 0, D>(lds, (const bf16_t*)((unsigned char*)p.out + OY_H1), (const bf16_t*)(p.ws + WS_WIN), E);
    }
    SEAM(2);
    if (IN(3)) { phase2(p, lds);
    }
    SEAM(3);
    if (IN(4)) phase3(p, lds);
    SEAM(4);
    if (IN(5)) { phase4(p, lds);
    }
    SEAM(5);
    if (IN(6)) {
        { EpiProj<0> E{p.ws}; pg8::gemm_phase<EpiProj<0>, true, 128, 4, 0, D>(lds, (const bf16_t*)((unsigned char*)p.out + OY_YA), (const bf16_t*)(p.ws + WS_WPA), E); }
        small_gemm<0, D>(p, lds, (const bf16_t*)((unsigned char*)p.out + OY_YA), (const bf16_t*)(p.ws + WS_WPA));
        { EpiProj<1> E{p.ws}; pg8::gemm_phase<EpiProj<1>, true, 128, 4, 0, D>(lds, (const bf16_t*)((unsigned char*)p.out + OY_YB), (const bf16_t*)(p.ws + WS_WPB), E); }
        small_gemm<1, D>(p, lds, (const bf16_t*)((unsigned char*)p.out + OY_YB), (const bf16_t*)(p.ws + WS_WPB));
    }
    SEAM(6);
    if (IN(7)) { EpiRes<0> E{p.ws, p.out, lds}; pg8::gemm_phase<EpiRes<0>, true, 128, 4, 0, D>(lds, (const bf16_t*)(p.ws + WS_MG), (const bf16_t*)(p.ws + WS_WO), E);
        small_gemm<2, D>(p, lds, (const bf16_t*)(p.ws + WS_MG), (const bf16_t*)(p.ws + WS_WO)); }
    SEAM(7);
    if (IN(8)) phase7(p, lds);
    SEAM(8);
    if (IN(9)) { EpiUp E{p.ws, p.out, lds}; pg8::gemm_phase<EpiUp, true, 136, 22, 1, D, true>(lds, (const bf16_t*)((unsigned char*)p.out + OY_H2), (const bf16_t*)(p.ws + WS_WUP), E); }
    SEAM(9);
    if (IN(10)) { EpiRes<1> E{p.ws, p.out, lds}; pg8::gemm_phase<EpiRes<1>, true, 128, 4, 0, DFF>(lds, (const bf16_t*)(p.ws + WS_ACT), (const bf16_t*)(p.ws + WS_WD), E);
        small_gemm<3, DFF>(p, lds, (const bf16_t*)(p.ws + WS_ACT), (const bf16_t*)(p.ws + WS_WD)); }
    SEAM(10);
    if (IN(11)) ln_rows<false>(p, lds);
}

template <int K> static void launch_one(Params& p, int grid, hipStream_t stream) {
    hipFuncSetAttribute((const void*)mk_fwd<K, K + 1>, hipFuncAttributeMaxDynamicSharedMemorySize, LDS_BYTES);
    const int reps = 1 + ((PROBE_MASK >> K) & 1);
    for (int r = 0; r < reps; ++r) hipLaunchKernelGGL((mk_fwd<K, K + 1>), dim3(grid), dim3(512), LDS_BYTES, stream, p);
}
extern "C" void kernel_launch(void* const* d_in, const int* in_sizes, int n_in, void* d_out, int out_size, void* d_ws, size_t ws_size, hipStream_t stream) {
    static int grid_blocks = 0;
    if (!grid_blocks) {
        int dev = 0, cus = 0, per_cu = 0;
        (void)hipGetDevice(&dev);
        (void)hipDeviceGetAttribute(&cus, hipDeviceAttributeMultiprocessorCount, dev);
        (void)hipFuncSetAttribute((const void*)mk_fwd<0, NPH>, hipFuncAttributeMaxDynamicSharedMemorySize, LDS_BYTES);
        (void)hipOccupancyMaxActiveBlocksPerMultiprocessor(&per_cu, mk_fwd<0, NPH>, 512, LDS_BYTES);
        if (per_cu < 1) per_cu = 1;
        grid_blocks = cus * per_cu;
    }
    Params p{};
    for (int i = 0; i < 29; ++i) p.in[i] = (const float*)d_in[i];
    p.out = (float*)d_out; p.ws = (unsigned char*)d_ws; p.ph_lo = 0; p.ph_hi = NPH;
#ifdef PROBE_MULTI
    launch_one<0>(p, grid_blocks, stream); launch_one<1>(p, grid_blocks, stream); launch_one<2>(p, grid_blocks, stream); launch_one<3>(p, grid_blocks, stream);
    launch_one<4>(p, grid_blocks, stream); launch_one<5>(p, grid_blocks, stream); launch_one<6>(p, grid_blocks, stream); launch_one<7>(p, grid_blocks, stream);
    launch_one<8>(p, grid_blocks, stream); launch_one<9>(p, grid_blocks, stream); launch_one<10>(p, grid_blocks, stream); launch_one<11>(p, grid_blocks, stream);
#else
    (void)hipMemsetAsync((unsigned char*)d_ws + WS_BAR, 0, XCD_BAR_WORDS * 4, stream);
    void* args[] = {&p};
    hipError_t e = hipLaunchCooperativeKernel((const void*)mk_fwd<0, NPH>, dim3(grid_blocks), dim3(512), args, LDS_BYTES, stream);
    if (e != hipSuccess) fprintf(stderr, "cooperative launch failed: %s (grid %d)\n", hipGetErrorString(e), grid_blocks);
#endif
}
```

```cpp
#include <hip/hip_runtime.h>
#include <hip/hip_cooperative_groups.h>
#include <cstdio>
namespace cg = cooperative_groups;

#define DI __device__ __forceinline__
#define LAS __attribute__((address_space(3)))
typedef unsigned short bf16_t;
typedef short bf16x8 __attribute__((ext_vector_type(8)));
typedef short s16x4 __attribute__((ext_vector_type(4)));
typedef short v4i16_t __attribute__((ext_vector_type(4)));
typedef float f32x4 __attribute__((ext_vector_type(4)));
typedef float f32x2_t __attribute__((ext_vector_type(2)));
typedef __bf16 bf16x2_t __attribute__((ext_vector_type(2)));
typedef unsigned u32x4 __attribute__((ext_vector_type(4)));
typedef unsigned u32x2 __attribute__((ext_vector_type(2)));

constexpr int D = 1024, MP = 32768, MS = 1024, M = MP + MS, SEQ = 8192, DSEQ = 32;
constexpr int ZW = 6408, NZ = 6400, DFF = 2816, DFF2 = 5632;
constexpr float ALPHA = 1.189207115002721f;
constexpr float LN_EPS = 1e-5f;
constexpr size_t O_Y = 0;
constexpr size_t O_PK = (size_t)M * D;
constexpr size_t O_PV = O_PK + 65536;
constexpr size_t O_PC = O_PV + 65536;
constexpr size_t O_PN = O_PC + 524288;
constexpr size_t O_PM = O_PN + 2048;
constexpr size_t O_PCONV = O_PM + 16;
constexpr size_t O_SK = O_PCONV + 45056;
constexpr size_t O_SV = O_SK + 524288;
constexpr size_t O_SC = O_SV + 524288;
constexpr size_t O_SN = O_SC + 4194304;
constexpr size_t O_SM = O_SN + 16384;
constexpr size_t O_SCONV = O_SM + 128;
constexpr size_t WS_WIN = 0;
constexpr size_t WS_WPA = WS_WIN + (size_t)NZ * D * 2;
constexpr size_t WS_WPB = WS_WPA + (size_t)D * D * 2;
constexpr size_t WS_WO = WS_WPB + (size_t)D * D * 2;
constexpr size_t WS_MOD = WS_WO + (size_t)D * D * 2;
constexpr size_t WS_GI = WS_MOD + (size_t)36 * 6144 * 4;
constexpr size_t WS_GF = WS_GI + (size_t)M * 16;
constexpr size_t WS_MT = WS_GF + (size_t)M * 16;
constexpr size_t WS_BT = WS_MT + (size_t)M * 16;
constexpr size_t WS_CSN = WS_BT + (size_t)M * 16;
constexpr size_t WS_ZA = WS_CSN + (size_t)16 * 64 * 128 * 4;
constexpr size_t WS_ZB = WS_ZA + (size_t)M * 1280 * 2;
constexpr size_t WS_ZG = WS_ZB + (size_t)M * 2048 * 2;
constexpr size_t WS_CS = WS_ZG + (size_t)M * 3072 * 2;
constexpr size_t WS_END = WS_CS + (size_t)1024 * 32768 * 2;
constexpr size_t ZA_KA = (size_t)M * 1024 * 2, ZA_VA = ZA_KA + (size_t)2 * M * 64 * 2;
constexpr size_t ZB_KM = (size_t)4 * M * 128 * 2, ZB_VM = 2 * ZB_KM;
constexpr size_t ZG_GAB = (size_t)4 * M * 256 * 2;
constexpr size_t WS_WUP = WS_CS;
constexpr size_t WS_WD = WS_WUP + (size_t)DFF2 * D * 2;
constexpr size_t WS_MG = WS_ZA;
constexpr size_t WS_X1 = WS_ZB;
constexpr size_t WS_ACT = WS_ZG;
constexpr size_t WS_R1 = WS_ZG;
constexpr size_t WS_R2 = WS_ZA;
static_assert(WS_END <= 536870912, "ws");
constexpr size_t OY_H1 = 0;
constexpr size_t OY_YA = 0;
constexpr size_t OY_YB = (size_t)M * D * 2;
constexpr size_t OY_H2 = 1048576;

constexpr int LDS_BYTES = 147456;
constexpr int NPH = 12;

struct Params {
    const float* in[29];
    float* out;
    unsigned char* ws;
    int ph_lo, ph_hi;
};


constexpr int LDS_TAB = 146432;
DI const float* pin_ptr(LAS unsigned char* lds, int k) {
    const unsigned long long v = *(const LAS unsigned long long*)(lds + LDS_TAB + 8 * k);
    const unsigned lo = __builtin_amdgcn_readfirstlane((unsigned)v), hi = __builtin_amdgcn_readfirstlane((unsigned)(v >> 32));
    typedef const __attribute__((address_space(1))) float* gptr_t;
    const gptr_t g = (gptr_t)(((unsigned long long)hi << 32) | lo);
    return (const float*)g;
}
#define PIN(k) pin_ptr(lds, (k))
DI unsigned cvtpk(float lo, float hi) { f32x2_t v = {lo, hi}; bf16x2_t b = __builtin_convertvector(v, bf16x2_t); return __builtin_bit_cast(unsigned, b); }
DI float bflo(unsigned u) { return __uint_as_float(u << 16); }
DI float bfhi(unsigned u) { return __uint_as_float(u & 0xffff0000u); }
template <class T> DI T ntl(const T* p) { return __builtin_nontemporal_load(p); }
template <class T> DI void nts(T* p, T v) { __builtin_nontemporal_store(v, p); }
DI void swap16(unsigned& a, unsigned& b) { auto r = __builtin_amdgcn_permlane16_swap(a, b, false, false); a = r[0]; b = r[1]; }
DI void swap16x2(u32x4& v) { unsigned a = v.x, b = v.z; swap16(a, b); v.x = a; v.z = b; a = v.y; b = v.w; swap16(a, b); v.y = a; v.w = b; }
DI int opaque_tid() { int t = threadIdx.x; asm volatile("" : "+v"(t)); return t; }
DI float sigm(float x) { return __builtin_amdgcn_rcpf(1.f + __builtin_amdgcn_exp2f(-1.4426950408889634f * x)); }
DI s16x4 lds_tr(const LAS unsigned char* p) { return __builtin_bit_cast(s16x4, __builtin_amdgcn_ds_read_tr16_b64_v4i16((LAS v4i16_t*)p)); }
DI bf16x8 cat8(s16x4 lo, s16x4 hi) { return __builtin_shufflevector(lo, hi, 0, 1, 2, 3, 4, 5, 6, 7); }
DI float ror1(float v) { return __builtin_bit_cast(float, __builtin_amdgcn_update_dpp(0, __builtin_bit_cast(int, v), 0x121, 0xf, 0xf, false)); }
DI float ror2(float v) { return __builtin_bit_cast(float, __builtin_amdgcn_update_dpp(0, __builtin_bit_cast(int, v), 0x122, 0xf, 0xf, false)); }
DI float wave_sum(float v) {
#pragma unroll
    for (int o = 1; o < 64; o <<= 1) v += __shfl_xor(v, o);
    return v;
}
DI int crow_of(int row) { return row < MP ? (row >> 13) : 4 + ((row - MP) >> 5); }
DI const float* xrow_of(const float* xp, const float* xs, int row) { return row < MP ? xp + (size_t)row * D : xs + (size_t)(row - MP) * D; }
#define MFMA16(a, b, c) __builtin_amdgcn_mfma_f32_16x16x32_bf16((a), (b), (c), 0, 0, 0)

namespace pg8 {
constexpr int BM = 256, BK = 64, HALF = 128, HTB = HALF * BK * 2, NXCD = 8, WGM = 4;
DI int lds_byte(int r, int c) { const int st = (r >> 4) * 2 + (c >> 5), rr = r & 15, cc = c & 31, ob = rr * 64 + cc * 2; return st * 1024 + (ob ^ (((ob >> 9) & 1) << 5)); }
DI void stage_rc(int b, int& R, int& C) { const int st = b / 1024, sb = b % 1024, swz = sb ^ (((sb >> 9) & 1) << 5); R = (st >> 1) * 16 + swz / 64; C = (st & 1) * 32 + (swz % 64) / 2; }
DI int perm32(int rho) { const int n = rho >> 4, i = rho & 15; return 8 * (i >> 2) + 4 * n + (i & 3); }
struct Unit { int pm, pn; };
struct Gemm { const bf16_t* A; const bf16_t* Bt; int K; };
template <int NM, int NN, int MODE> struct Sched {
    static constexpr int nM = NM, nN = NN, nwg = NM * NN;
    DI bool next(int i, Unit& u) const {
        const int G = gridDim.x, c = blockIdx.x;
        const long L = (long)i * G + c; if (L >= nwg) return false;
        int wgid = (int)L; { constexpr int q = nwg / NXCD, r = nwg % NXCD; const int xcd = wgid % NXCD, off = wgid / NXCD; wgid = (xcd < r ? xcd * (q + 1) : r * (q + 1) + (xcd - r) * q) + off; }
        constexpr int nig = WGM * nN; const int gid = wgid / nig, fm = gid * WGM, gsz = (nM - fm) < WGM ? (nM - fm) : WGM;
        u.pm = fm + ((wgid % nig) % gsz); u.pn = (wgid % nig) / gsz; return true;
    }
    DI long arow(const Unit& u) const {
        if (MODE == 0) return (long)u.pm * BM;
        if (u.pm < 132) { const int s = u.pm / 33, i = u.pm - s * 33; return (long)s * SEQ + 254 * i - 2; }
        return (long)MP + (long)(u.pm - 132) * BM;
    }
};

template <class Epi, bool ALIGN_EPI, int NM, int NN, int MODE, int KK, bool ROWPERM = false>
DI void gemm_phase(LAS unsigned char* lds, const bf16_t* gA, const bf16_t* gBt, const Epi& E) {
    const Sched<NM, NN, MODE> S;
    const int tid = opaque_tid(), wid = __builtin_amdgcn_readfirstlane(tid >> 6), lane = tid & 63, wr = wid >> 2, wc = wid & 3, fr = lane & 15, fq = lane >> 4;
    constexpr int K = KK, nt = K / BK;
    unsigned voffA[2], voffB[2];
#pragma unroll
    for (int i = 0; i < 2; ++i) { int R, C; stage_rc(tid * 16 + i * 8192, R, C); const int Rb = (R & ~31) + perm32(R & 31);
        const int Ra = ROWPERM ? (128 * (R >> 6) + (R & 63)) : R;
        voffA[i] = (unsigned)(Ra * K + C) * 2u; voffB[i] = (unsigned)(Rb * K + C) * 2u; }
    const size_t kstep = (size_t)(BK * 2);
    const size_t hstep = (size_t)HALF * K * 2;
    const size_t hstepA = ROWPERM ? (size_t)64 * K * 2 : hstep;
    const size_t tstep = 2 * hstep;
    const long rowb = (long)K * 2;
    const unsigned ldsw = (unsigned)wid * 1024u;
    const int aoff = lds_byte(wr * 64 + fr, fq * 8), boff = lds_byte(wc * 32 + fr, fq * 8);
#define PG8_SA(b, h) (((b) * 2 + (h)) * HTB)
#define PG8_SB(b, h) ((4 + (b) * 2 + (h)) * HTB)
#define PG8_STAGE(bufoff, gbase, voff) do { _Pragma("unroll") for (int _i = 0; _i < 2; ++_i) \
        __builtin_amdgcn_global_load_lds((const unsigned*)((const char*)(gbase) + (voff)[_i]), (LAS unsigned*)(lds + (bufoff) + ldsw + _i * 8192), 16, 0, 0); } while (0)
#define PG8_LDA(dst, b, h) do { _Pragma("unroll") for (int m = 0; m < 4; ++m) _Pragma("unroll") for (int k = 0; k < 2; ++k) dst[m][k] = *(const LAS bf16x8*)(lds + PG8_SA(b, h) + aoff + m * 2048 + k * 1024); } while (0)
#define PG8_LDB(dst, b, h) do { _Pragma("unroll") for (int n = 0; n < 2; ++n) _Pragma("unroll") for (int k = 0; k < 2; ++k) dst[n][k] = *(const LAS bf16x8*)(lds + PG8_SB(b, h) + boff + n * 2048 + k * 1024); } while (0)
#define PG8_MMA(ai, bj, At, Bt) do { __builtin_amdgcn_s_setprio(1); _Pragma("unroll") for (int m = 0; m < 4; ++m) _Pragma("unroll") for (int n = 0; n < 2; ++n) _Pragma("unroll") for (int k = 0; k < 2; ++k) \
        acc[ai][bj][m][n] = __builtin_amdgcn_mfma_f32_16x16x32_bf16(Bt[n][k], At[m][k], acc[ai][bj][m][n], 0, 0, 0); __builtin_amdgcn_s_setprio(0); } while (0)
#define PG8_WAIT_V(n) asm volatile("s_waitcnt vmcnt(" #n ")" ::: "memory")
#define PG8_WAIT_L(n) asm volatile("s_waitcnt lgkmcnt(" #n ")" ::: "memory")
#define PG8_BAR __builtin_amdgcn_s_barrier()
#define PG8_SCHED __builtin_amdgcn_sched_barrier(0)
    Unit cur, nxt; int ui = 0;
    if (!S.next(0, cur)) return;
    f32x4 acc[2][2][4][2];
#pragma unroll
    for (int a = 0; a < 2; ++a)
#pragma unroll
        for (int b = 0; b < 2; ++b)
#pragma unroll
            for (int m = 0; m < 4; ++m)
#pragma unroll
                for (int n = 0; n < 2; ++n) acc[a][b][m][n] = (f32x4){0.f, 0.f, 0.f, 0.f};
    bf16x8 At[4][2], B0[2][2], B1[2][2];
    const char* cA = (const char*)gA + S.arow(cur) * rowb; const char* cB = (const char*)gBt + (size_t)cur.pn * tstep;
    PG8_STAGE(PG8_SB(0, 0), cB, voffB); PG8_STAGE(PG8_SB(0, 1), cB + hstep, voffB); PG8_STAGE(PG8_SA(0, 0), cA, voffA); PG8_STAGE(PG8_SA(0, 1), cA + hstepA, voffA);
    if (wr == 1) PG8_BAR;
    PG8_WAIT_V(2); PG8_BAR;
    PG8_STAGE(PG8_SB(1, 0), cB + kstep, voffB); PG8_STAGE(PG8_SA(1, 0), cA + kstep, voffA); PG8_STAGE(PG8_SB(1, 1), cB + hstep + kstep, voffB);
    PG8_WAIT_V(6); PG8_BAR;
    for (;;) {
        const bool has_next = S.next(ui + 1, nxt);
        const char* nA = has_next ? (const char*)gA + S.arow(nxt) * rowb : cA; const char* nB = has_next ? (const char*)gBt + (size_t)nxt.pn * tstep : cB;
        for (int t = 0; t < nt; t += 2) {
            const bool last = (t == nt - 2);
            const char* a1 = cA + (size_t)(t + 1) * kstep;
            const char* a2 = last ? nA : cA + (size_t)(t + 2) * kstep; const char* b2 = last ? nB : cB + (size_t)(t + 2) * kstep;
            const char* a3 = a2 + kstep; const char* b3 = b2 + kstep;
            PG8_LDB(B0, 0, 0); PG8_LDB(B1, 0, 1); PG8_SCHED; PG8_LDA(At, 0, 0); PG8_STAGE(PG8_SA(1, 1), a1 + hstepA, voffA);
            PG8_WAIT_V(8); PG8_WAIT_L(0); PG8_BAR; PG8_MMA(0, 0, At, B0); PG8_MMA(0, 1, At, B1); PG8_BAR; PG8_SCHED;
            PG8_LDA(At, 0, 1); PG8_STAGE(PG8_SB(0, 0), b2, voffB); PG8_STAGE(PG8_SB(0, 1), b2 + hstep, voffB); PG8_STAGE(PG8_SA(0, 0), a2, voffA);
            PG8_WAIT_V(8); PG8_WAIT_L(0); PG8_BAR; PG8_MMA(1, 0, At, B0); PG8_MMA(1, 1, At, B1); PG8_BAR; PG8_SCHED;
            PG8_LDB(B0, 1, 0); PG8_LDB(B1, 1, 1); PG8_SCHED; PG8_LDA(At, 1, 0); PG8_STAGE(PG8_SA(0, 1), a2 + hstepA, voffA);
            PG8_WAIT_V(8); PG8_WAIT_L(0); PG8_BAR; PG8_MMA(0, 0, At, B0); PG8_MMA(0, 1, At, B1); PG8_BAR; PG8_SCHED;
            PG8_LDA(At, 1, 1); PG8_STAGE(PG8_SB(1, 0), b3, voffB); PG8_STAGE(PG8_SB(1, 1), b3 + hstep, voffB); PG8_STAGE(PG8_SA(1, 0), a3, voffA);
            PG8_WAIT_V(8); PG8_WAIT_L(0); PG8_BAR; PG8_MMA(1, 0, At, B0); PG8_MMA(1, 1, At, B1); PG8_BAR; PG8_SCHED;
        }
        if constexpr (ALIGN_EPI) { if (wr == 0) PG8_BAR; }
        E(acc, cur, wr, wc, fr, fq);
        if (!has_next) break;
#pragma unroll
        for (int a = 0; a < 2; ++a)
#pragma unroll
            for (int b = 0; b < 2; ++b)
#pragma unroll
                for (int m = 0; m < 4; ++m)
#pragma unroll
                    for (int n = 0; n < 2; ++n) acc[a][b][m][n] = (f32x4){0.f, 0.f, 0.f, 0.f};
        cur = nxt; cA = nA; cB = nB; ++ui;
        if constexpr (ALIGN_EPI) { if (wr == 1) PG8_BAR; }
    }
    PG8_WAIT_V(0);
    if constexpr (!ALIGN_EPI) { if (wr == 0) PG8_BAR; }
    PG8_BAR;
#undef PG8_SA
#undef PG8_SB
#undef PG8_STAGE
#undef PG8_LDA
#undef PG8_LDB
#undef PG8_MMA
#undef PG8_WAIT_V
#undef PG8_WAIT_L
#undef PG8_BAR
#undef PG8_SCHED
}
}
using pg8::Unit;
typedef f32x4 AccT[2][2][4][2];

struct EpiWin {
    unsigned char* ws; float* out;
    DI void operator()(const AccT& acc, const Unit& u, int wr, int wc, int fr, int fq) const {
        asm volatile("" : "+v"(fr), "+v"(fq));
        const int pn = u.pn; const int row0 = u.pm * 256 + wr * 64 + fr;
        const int c128 = wc * 32 + 8 * fq;
        bf16_t* base0; unsigned bjoff = 128, rstride; float sc = 1.f; bool sg = false;
        if (pn < 4) { base0 = (bf16_t*)(ws + WS_ZA) + pn * 256 + c128; rstride = 1024; }
        else if (pn == 4) { const int kvh = c128 >> 6, d = c128 & 63; base0 = (bf16_t*)(ws + WS_ZA + ZA_KA) + (size_t)kvh * M * 64 + d; bjoff = (unsigned)((ZA_VA - ZA_KA) / 2); rstride = 64; }
        else if (pn < 9) { const int hb = ((pn - 5) & 1) * 2; base0 = (bf16_t*)(ws + WS_ZB + (pn >= 7 ? ZB_KM : 0)) + (size_t)hb * M * 128 + c128; bjoff = (unsigned)M * 128u; rstride = 128; if (pn >= 7) sc = 0.08838834764831845f; }
        else if (pn < 13) { base0 = (bf16_t*)(ws + WS_ZB + ZB_VM) + (size_t)(pn - 9) * M * 256 + c128; rstride = 256; }
        else if (pn < 17) { base0 = (bf16_t*)(ws + WS_ZG) + (size_t)(pn - 13) * M * 256 + c128; rstride = 256; sg = true; }
        else { base0 = (bf16_t*)(ws + WS_ZG + ZG_GAB) + (pn - 17) * 256 + c128; rstride = 2048; sg = true; }
#pragma unroll
        for (int ai = 0; ai < 2; ++ai)
#pragma unroll
            for (int m = 0; m < 4; ++m) {
                const int row = row0 + ai * 128 + m * 16;
#pragma unroll
                for (int bj = 0; bj < 2; ++bj) {
                    f32x4 v0 = acc[ai][bj][m][0], v1 = acc[ai][bj][m][1];
                    if (pn == 4) {
                        float* dst = nullptr;
                        if (row < MP) { const int n = row >> 13, t = row & 8191; if (t >= SEQ - 128) dst = out + (bj ? O_PV : O_PK) + ((size_t)(n * 128 + t - (SEQ - 128))) * 128 + c128; }
                        else { const int rs = row - MP, n = rs >> 5, t = rs & 31; dst = out + (bj ? O_SV : O_SK) + ((size_t)(n * 128 + 96 + t)) * 128 + c128; }
                        if (dst) { *(f32x4*)dst = v0; *(f32x4*)(dst + 4) = v1; }
                    }
                    if (sg) {
#pragma unroll
                        for (int e = 0; e < 4; ++e) { v0[e] = sigm(v0[e]); v1[e] = sigm(v1[e]); }
                    } else { v0 = v0 * sc; v1 = v1 * sc; }
                    u32x4 w; w.x = cvtpk(v0[0], v0[1]); w.y = cvtpk(v0[2], v0[3]); w.z = cvtpk(v1[0], v1[1]); w.w = cvtpk(v1[2], v1[3]);
                    *(u32x4*)(base0 + ((size_t)row * rstride + (bj ? bjoff : 0u))) = w;
                }
            }
    }
};
template <int WHICH> struct EpiProj {
    unsigned char* ws;
    DI void operator()(const AccT& acc, const Unit& u, int wr, int wc, int fr, int fq) const {
        bf16_t* MG = (bf16_t*)(ws + WS_MG); const bf16_t* zG = (const bf16_t*)(ws + WS_ZG + ZG_GAB);
        const int row0 = u.pm * 256 + wr * 64 + fr, col0 = u.pn * 256 + wc * 32 + 8 * fq;
#pragma unroll
        for (int ai = 0; ai < 2; ++ai) {
            u32x4 gt[4][2], od[4][2];
#pragma unroll
            for (int m = 0; m < 4; ++m)
#pragma unroll
                for (int bj = 0; bj < 2; ++bj) {
                    const unsigned row = row0 + ai * 128 + m * 16, col = col0 + bj * 128;
                    gt[m][bj] = ntl((const u32x4*)(zG + (size_t)(row * 2048u + WHICH * 1024u + col)));
                    if (WHICH == 1) od[m][bj] = *(const u32x4*)(MG + (size_t)(row * 1024u + col));
                }
#pragma unroll
            for (int m = 0; m < 4; ++m)
#pragma unroll
                for (int bj = 0; bj < 2; ++bj) {
                    const unsigned row = row0 + ai * 128 + m * 16, col = col0 + bj * 128;
                    const u32x4 g = gt[m][bj];
                    f32x4 v0 = acc[ai][bj][m][0], v1 = acc[ai][bj][m][1];
                    v0[0] *= bflo(g.x); v0[1] *= bfhi(g.x); v0[2] *= bflo(g.y); v0[3] *= bfhi(g.y);
                    v1[0] *= bflo(g.z); v1[1] *= bfhi(g.z); v1[2] *= bflo(g.w); v1[3] *= bfhi(g.w);
                    if (WHICH == 1) { const u32x4 o = od[m][bj];
                        v0[0] += bflo(o.x); v0[1] += bfhi(o.x); v0[2] += bflo(o.y); v0[3] += bfhi(o.y);
                        v1[0] += bflo(o.z); v1[1] += bfhi(o.z); v1[2] += bflo(o.w); v1[3] += bfhi(o.w); }
                    u32x4 w; w.x = cvtpk(v0[0], v0[1]); w.y = cvtpk(v0[2], v0[3]); w.z = cvtpk(v1[0], v1[1]); w.w = cvtpk(v1[2], v1[3]);
                    *(u32x4*)(MG + (size_t)(row * 1024u + col)) = w;
                }
        }
    }
};
template <int V> struct EpiRes {
    unsigned char* ws; float* out; LAS unsigned char* lds;
    DI void operator()(const AccT& acc, const Unit& u, int wr, int wc, int fr, int fq) const {
        bf16_t* dst = (bf16_t*)(ws + (V == 0 ? WS_R1 : WS_R2));
        const float* mod = (const float*)(ws + WS_MOD); constexpr int goff = V == 0 ? 2048 : 5120;
        const int row0 = u.pm * 256 + wr * 64 + fr, col0 = u.pn * 256 + wc * 32 + 8 * fq;
        const bool uni = u.pm < 128;
        f32x4 gu[2][2];
        if (uni) { const float* gp = mod + (size_t)(u.pm >> 5) * 6144 + goff + col0;
#pragma unroll
            for (int bj = 0; bj < 2; ++bj)
#pragma unroll
                for (int n = 0; n < 2; ++n) gu[bj][n] = *(const f32x4*)(gp + bj * 128 + 4 * n); }
#pragma unroll
        for (int ai = 0; ai < 2; ++ai)
#pragma unroll
            for (int m = 0; m < 4; ++m) {
                const int row = row0 + ai * 128 + m * 16;
                const float* gp = mod + (size_t)crow_of(row) * 6144 + goff + col0;
#pragma unroll
                for (int bj = 0; bj < 2; ++bj) {
                    const f32x4 g0 = uni ? gu[bj][0] : *(const f32x4*)(gp + bj * 128), g1 = uni ? gu[bj][1] : *(const f32x4*)(gp + bj * 128 + 4);
                    const f32x4 v0 = g0 * acc[ai][bj][m][0], v1 = g1 * acc[ai][bj][m][1];
                    u32x4 w; w.x = cvtpk(v0[0], v0[1]); w.y = cvtpk(v0[2], v0[3]); w.z = cvtpk(v1[0], v1[1]); w.w = cvtpk(v1[2], v1[3]);
                    *(u32x4*)(dst + (size_t)row * D + col0 + bj * 128) = w;
                }
            }
    }
};
struct EpiUp {
    unsigned char* ws; float* out; LAS unsigned char* lds;
    DI void operator()(const AccT& acc, const Unit& u, int wr, int wc, int fr, int fq) const {
        bf16_t* act = (bf16_t*)(ws + WS_ACT); const float* b_up = PIN(23); const float* conv_w = PIN(24); const float* conv_b = PIN(25); const float* st_conv = PIN(7); LAS float* bnd = (LAS float*)(lds + 131072);
        const bool sample = u.pm >= 132;
        int seq = 0, tbase = 0;
        if (!sample) { seq = u.pm / 33; tbase = 254 * (u.pm - seq * 33) - 2; }
        const int cc = wc * 32 + 8 * fq;
        const int ca = u.pn * 128 + cc;
        LAS float* kc = (LAS float*)(lds + 131072 + 4096);
        {
            const int t = threadIdx.x;
#pragma unroll
            for (int i = 0; i < 3; ++i) { const int idx = t + 512 * i;
                if (idx < 1280) { const int arr = idx >> 7, c = idx & 127;
                    const float* src = arr < 2 ? b_up + arr * DFF : arr < 8 ? conv_w + (arr < 5 ? (arr - 2) * DFF2 : (arr - 5) * DFF2 + DFF) : conv_b + (arr - 8) * DFF;
                    kc[idx] = src[u.pn * 128 + c]; } }
        }
        if (wr == 0 && fr >= 14) {
#pragma unroll
            for (int bj = 0; bj < 2; ++bj)
#pragma unroll
                for (int n = 0; n < 2; ++n) {
                    *(LAS f32x4*)(bnd + ((fr - 14) * 256 + bj * 128 + cc + 4 * n)) = acc[1][bj][3][n] + *(const f32x4*)(b_up + bj * DFF + ca + 4 * n);
                }
        }
        __syncthreads();
#pragma unroll
        for (int n = 0; n < 2; ++n) {
            const int col = ca + 4 * n;
            const LAS float* kq = kc + cc + 4 * n;
            const f32x4 ba = *(const LAS f32x4*)kq, bg = *(const LAS f32x4*)(kq + 128), w0a = *(const LAS f32x4*)(kq + 256), w1a = *(const LAS f32x4*)(kq + 384), w2a = *(const LAS f32x4*)(kq + 512),
                        w0g = *(const LAS f32x4*)(kq + 640), w1g = *(const LAS f32x4*)(kq + 768), w2g = *(const LAS f32x4*)(kq + 896), cba = *(const LAS f32x4*)(kq + 1024), cbg = *(const LAS f32x4*)(kq + 1152);
            f32x4 c1a, c2a, c1g, c2g;
#pragma unroll
            for (int ai = 0; ai < 2; ++ai) {
                if (ai == 0) {
                    c1a = (f32x4){0.f, 0.f, 0.f, 0.f}; c2a = c1a; c1g = c1a; c2g = c1a;
                    if (wr == 1) {
                        const LAS float* b14 = bnd + cc + 4 * n;
                        const LAS float* b15 = b14 + 256;
                        const f32x4 r14a = *(const LAS f32x4*)b14, r15a = *(const LAS f32x4*)b15, r14g = *(const LAS f32x4*)(b14 + 128), r15g = *(const LAS f32x4*)(b15 + 128);
                        c1a = r15a; c1g = r15g;
#pragma unroll
                        for (int e = 0; e < 4; ++e) { c2a[e] = fr == 0 ? r14a[e] : r15a[e]; c2g[e] = fr == 0 ? r14g[e] : r15g[e]; }
                    }
                }
#pragma unroll
                for (int m = 0; m < 4; ++m) {
                    const int tr = 128 * wr + 64 * ai + 16 * m + fr;
                    const int tl = sample ? ((16 * m + fr) & 31) : tbase + tr;
                    f32x4 va = acc[ai][0][m][n] + ba, vg = acc[ai][1][m][n] + bg;
                    if (!sample && tl < 0) { va = (f32x4){0.f, 0.f, 0.f, 0.f}; vg = va; }
                    int ns = 0;
                    if (sample) {
                        ns = ((u.pm - 132) * 256 + 128 * wr + 64 * ai + 16 * m) >> 5;
                        if ((m & 1) == 0) {
                            const float* s0 = st_conv + (size_t)(ns * 2) * DFF2 + col;
                            const f32x4 s0a = *(const f32x4*)s0, s1a = *(const f32x4*)(s0 + DFF2), s0g = *(const f32x4*)(s0 + DFF), s1g = *(const f32x4*)(s0 + DFF2 + DFF);
                            c1a = s1a; c1g = s1g;
#pragma unroll
                            for (int e = 0; e < 4; ++e) { c2a[e] = fr == 0 ? s0a[e] : s1a[e]; c2g[e] = fr == 0 ? s0g[e] : s1g[e]; }
                        }
                    }
                    f32x4 t1a, t2a, t1g, t2g, res;
#pragma unroll
                    for (int e = 0; e < 4; ++e) {
                        t1a[e] = ror1(va[e]); t2a[e] = ror2(va[e]); t1g[e] = ror1(vg[e]); t2g[e] = ror2(vg[e]);
                        const float p1a = fr >= 1 ? t1a[e] : c1a[e], p2a = fr >= 2 ? t2a[e] : c2a[e];
                        const float p1g = fr >= 1 ? t1g[e] : c1g[e], p2g = fr >= 2 ? t2g[e] : c2g[e];
                        const float ua = cba[e] + w0a[e] * p2a + w1a[e] * p1a + w2a[e] * va[e];
                        const float ug = cbg[e] + w0g[e] * p2g + w1g[e] * p1g + w2g[e] * vg[e];
                        const float y2 = 1.5957691216057308f * (ug + 0.044715f * ug * ug * ug);
                        res[e] = ua * ug * sigm(y2);
                    }
                    c1a = t1a; c2a = t2a; c1g = t1g; c2g = t2g;
                    const bool valid = sample ? true : (tr >= 2 && tl < SEQ);
                    if (valid) {
                        const size_t grow = sample ? (size_t)MP + (size_t)(u.pm - 132) * 256 + tr : (size_t)seq * SEQ + tl;
                        u32x2 w; w.x = cvtpk(res[0], res[1]); w.y = cvtpk(res[2], res[3]);
                        *(u32x2*)(act + grow * DFF + col) = w;
                        const int lastt = sample ? DSEQ - 2 : SEQ - 2;
                        if (tl >= lastt) {
                            float* dst = sample ? out + O_SCONV + (size_t)(ns * 2 + (tl - lastt)) * DFF2 + col : out + O_PCONV + (size_t)(seq * 2 + (tl - lastt)) * DFF2 + col;
                            *(f32x4*)dst = va; *(f32x4*)(dst + DFF) = vg;
                        }
                    }
                }
            }
        }
    }
};

DI void wtrans_item(const float* W, int ldw, int k0, int n0src, bf16_t* WT, int ldt, int n0dst, LAS float* scr, int lane) {
    float tv[32];
#pragma unroll
    for (int i = 0; i < 32; ++i) { const int kk = 2 * i + (lane >> 5); tv[i] = ntl(W + (size_t)(k0 + kk) * ldw + n0src + (lane & 31)); }
#pragma unroll
    for (int i = 0; i < 32; ++i) { const int kk = 2 * i + (lane >> 5); scr[kk * 33 + (lane & 31)] = tv[i]; }
    asm volatile("s_waitcnt lgkmcnt(0)" ::: "memory");
    const int c = lane & 7;
#pragma unroll
    for (int j = 0; j < 4; ++j) { const int n = (lane >> 3) + 8 * j; const LAS float* s = scr + (8 * c) * 33 + n;
        u32x4 o; o.x = cvtpk(s[0], s[33]); o.y = cvtpk(s[2 * 33], s[3 * 33]); o.z = cvtpk(s[4 * 33], s[5 * 33]); o.w = cvtpk(s[6 * 33], s[7 * 33]);
        *(u32x4*)(WT + (size_t)(n0dst + n) * ldt + k0 + 8 * c) = o; }
    asm volatile("s_waitcnt lgkmcnt(0)" ::: "memory");
}
DI void mod_item(const Params& p, LAS unsigned char* lds, int ci, int tid) {
    LAS float* sc = (LAS float*)lds;
    LAS float* red = (LAS float*)(lds + 40960);
    LAS float* wt = (LAS float*)(lds + 40960);
    const float* w_ada = PIN(10); const float* b_ada = PIN(11); const float* cp = PIN(8); const float* cs = PIN(9);
    float* mod = (float*)(p.ws + WS_MOD);
    const int col = tid & 31, kg = tid >> 5, col0 = ci * 32;
    float acc[36];
#pragma unroll
    for (int r = 0; r < 36; ++r) acc[r] = 0.f;
    for (int ch = 0; ch < 4; ++ch) {
        __syncthreads();
#pragma unroll 6
        for (int i = 0; i < 18; ++i) { const int idx = tid + 512 * i, r = idx >> 8, kk = idx & 255;
            const float c = r < 4 ? cp[r * D + ch * 256 + kk] : cs[(r - 4) * D + ch * 256 + kk];
            sc[kk * 36 + r] = c * sigm(c); }
        {
            f32x4 wt4[4];
#pragma unroll
            for (int i = 0; i < 4; ++i) { const int idx4 = tid + 512 * i; wt4[i] = ntl((const f32x4*)(w_ada + (size_t)(ch * 256 + (idx4 >> 3)) * 6144 + col0 + 4 * (idx4 & 7))); }
#pragma unroll
            for (int i = 0; i < 4; ++i) { const int idx4 = tid + 512 * i; *(LAS f32x4*)(wt + (idx4 >> 3) * 32 + 4 * (idx4 & 7)) = wt4[i]; }
        }
        __syncthreads();
#pragma unroll
        for (int kk = 0; kk < 16; ++kk) {
            const float w = wt[(kg * 16 + kk) * 32 + col];
            const LAS f32x4* s = (const LAS f32x4*)(sc + (kg * 16 + kk) * 36);
#pragma unroll
            for (int q = 0; q < 9; ++q) { const f32x4 v = s[q]; acc[4 * q] += v[0] * w; acc[4 * q + 1] += v[1] * w; acc[4 * q + 2] += v[2] * w; acc[4 * q + 3] += v[3] * w; }
        }
    }
    __syncthreads();
#pragma unroll
    for (int r = 0; r < 36; ++r) red[(kg * 36 + r) * 32 + col] = acc[r];
    __syncthreads();
    for (int o = tid; o < 36 * 32; o += 512) { const int r = o >> 5, cc = o & 31; float sum = b_ada[col0 + cc];
#pragma unroll
        for (int q = 0; q < 16; ++q) sum += red[(q * 36 + r) * 32 + cc];
        mod[(size_t)r * 6144 + col0 + cc] = sum; }
    __syncthreads();
}
DI void phase0a(const Params& p, LAS unsigned char* lds) {
    const int tid = opaque_tid(), lane = tid & 63, wave = tid >> 6;
    for (int it = blockIdx.x; it < 192; it += gridDim.x) mod_item(p, lds, it, tid);
    LAS float* scr = (LAS float*)(lds + wave * 8448);
    constexpr int I_WIN = 16 * 200, I_SQ = 16 * 32;
    constexpr int NIT = I_WIN + 3 * I_SQ;
    const float* w_in = PIN(12);
    for (int it = blockIdx.x * 8 + wave; it < NIT; it += gridDim.x * 8) {
        int r = it;
        if (r < I_WIN) { const int kb = r / 200, nb = r - kb * 200; const int n0 = nb * 32; wtrans_item(w_in, ZW, kb * 64, n0 < 3328 ? n0 : n0 + 8, (bf16_t*)(p.ws + WS_WIN), D, n0, scr, lane); continue; } r -= I_WIN;
        const int which = r / I_SQ; r -= which * I_SQ;
        const float* W = which == 0 ? PIN(17) : which == 1 ? PIN(18) : PIN(19);
        bf16_t* WT = (bf16_t*)(p.ws + (which == 0 ? WS_WPA : which == 1 ? WS_WPB : WS_WO));
        wtrans_item(W, D, (r >> 5) * 64, (r & 31) * 32, WT, D, (r & 31) * 32, scr, lane);
    }
}
DI void phase0b(const Params& p, LAS unsigned char* lds) {
    const int tid = opaque_tid(), lane = tid & 63, wave = tid >> 6;
    LAS float* wg = (LAS float*)lds;
    for (int i = tid; i < 8192; i += 512) { const int k = i >> 3, g = i & 7; const int chunk = k >> 2;
        wg[g * 1024 + ((chunk & 1) ? 512 : 0) + (chunk >> 1) * 4 + (k & 3)] = PIN(12)[(size_t)k * ZW + 3328 + g]; }
    __syncthreads();
    const float* mod = (const float*)(p.ws + WS_MOD);
    bf16_t* h1 = (bf16_t*)((unsigned char*)p.out + OY_H1);
    float* GI = (float*)(p.ws + WS_GI); float* GF = (float*)(p.ws + WS_GF);
    const float* xp0 = PIN(0); const float* xs0 = PIN(1); const float* bi_g = PIN(13); const float* bf_g = PIN(14);
    for (int rp = blockIdx.x * 8 + wave; rp < M / 2; rp += gridDim.x * 8) {
        float a8[2][8];
#pragma unroll
        for (int q = 0; q < 2; ++q)
#pragma unroll
            for (int g = 0; g < 8; ++g) a8[q][g] = 0.f;
#pragma unroll
        for (int q = 0; q < 2; ++q) {
            const int row = rp * 2 + q;
            const float* xr = xrow_of(xp0, xs0, row); const float* mr = mod + (size_t)crow_of(row) * 6144;
#pragma unroll
            for (int i = 0; i < 2; ++i) {
                const int c = 8 * lane + 512 * i;
                const f32x4 xa = ntl((const f32x4*)(xr + c)), xb = ntl((const f32x4*)(xr + c + 4));
                const f32x4 ha = xa * (*(const f32x4*)(mr + 1024 + c) + 1.f) + *(const f32x4*)(mr + c);
                const f32x4 hb = xb * (*(const f32x4*)(mr + 1024 + c + 4) + 1.f) + *(const f32x4*)(mr + c + 4);
                u32x4 w; w.x = cvtpk(ha[0], ha[1]); w.y = cvtpk(ha[2], ha[3]); w.z = cvtpk(hb[0], hb[1]); w.w = cvtpk(hb[2], hb[3]);
                *(u32x4*)(h1 + (size_t)row * D + c) = w;
                const int wo = (lane + 64 * i) * 4;
#pragma unroll
                for (int g = 0; g < 8; ++g) { const f32x4 wa = *(const LAS f32x4*)(wg + g * 1024 + wo), wb = *(const LAS f32x4*)(wg + g * 1024 + 512 + wo);
                    a8[q][g] += (ha[0] * wa[0] + ha[1] * wa[1] + ha[2] * wa[2] + ha[3] * wa[3]) + (hb[0] * wb[0] + hb[1] * wb[1] + hb[2] * wb[2] + hb[3] * wb[3]); }
            }
        }
#pragma unroll
        for (int q = 0; q < 2; ++q)
#pragma unroll
            for (int g = 0; g < 8; ++g) a8[q][g] = wave_sum(a8[q][g]);
        if (lane < 16) {
            const int q = lane >> 3, gl = lane & 7;
            float v = 0.f;
#pragma unroll
            for (int qq = 0; qq < 2; ++qq)
#pragma unroll
                for (int g = 0; g < 8; ++g) v = (q == qq && gl == g) ? a8[qq][g] : v;
            const int row = rp * 2 + q;
            if (gl < 4) GI[(size_t)row * 4 + gl] = v + bi_g[gl];
            else { const float xx = v + bf_g[gl - 4]; GF[(size_t)row * 4 + gl - 4] = fminf(xx, 0.f) - log1pf(__expf(-fabsf(xx))); }
        }
    }
    for (int i = blockIdx.x * 512 + tid; i < 32 * 96 * 32; i += gridDim.x * 512) {
        const int n = i / (96 * 32), rem = i - n * (96 * 32);
        const size_t so = ((size_t)n * 128 + 32) * 128 + (size_t)rem * 4, dof = (size_t)n * 128 * 128 + (size_t)rem * 4;
        *(f32x4*)(p.out + O_SK + dof) = *(const f32x4*)(PIN(2) + so);
        *(f32x4*)(p.out + O_SV + dof) = *(const f32x4*)(PIN(3) + so);
    }
}
DI void scan_step(float& A, float& C, int lane) {
#pragma unroll
    for (int off = 1; off < 64; off <<= 1) {
        const float Ap = __shfl_up(A, off), Cp = __shfl_up(C, off);
        if (lane >= off) { C = fmaxf(Cp + A, C); A = Ap + A; }
    }
}
DI void mscan(const Params& p, LAS unsigned char* lds) {
    const int tid = opaque_tid(), lane = tid & 63, wave = tid >> 6;
    const int G = gridDim.x, rb = G - 1 - (int)blockIdx.x;
    const float* GI = (const float*)(p.ws + WS_GI); const float* GF = (const float*)(p.ws + WS_GF);
    float* MT = (float*)(p.ws + WS_MT); float* BT = (float*)(p.ws + WS_BT);
    LAS float* la = (LAS float*)lds; LAS float* lc = la + SEQ;
    for (int ch = rb; ch < 16; ch += G) {
        const int n = ch >> 2, hh = ch & 3;
        __syncthreads();
        for (int t = tid; t < SEQ; t += 512) { const size_t r = ((size_t)n * SEQ + t) * 4 + hh; la[t] = GF[r]; lc[t] = GI[r]; }
        __syncthreads();
        if (wave == 0) {
            float mcar = 0.f, bcar = 0.f;
            for (int it = 0; it < SEQ / 64; ++it) {
                float A = la[it * 64 + lane], C = lc[it * 64 + lane];
                scan_step(A, C, lane);
                const float mt = fmaxf(mcar + A, C);
                const float b = A + ((it & 1) ? bcar : 0.f);
                const size_t r = ((size_t)n * SEQ + it * 64 + lane) * 4 + hh;
                MT[r] = mt; BT[r] = b;
                mcar = __shfl(mt, 63); bcar = __shfl(A, 63);
            }
            if (lane == 0) p.out[O_PM + ch] = mcar;
        }
    }
    if (rb >= 16) {
        for (int sid = (rb - 16) * 8 + wave; sid < 128; sid += (G - 16) * 8) {
            const int n = sid >> 2, hh = sid & 3;
            const size_t r = ((size_t)MP + n * DSEQ + (lane & 31)) * 4 + hh;
            float A = GF[r], C = GI[r];
            const float m0 = PIN(6)[sid];
            scan_step(A, C, lane);
            const float mt = fmaxf(m0 + A, C);
            if (lane < 32) { MT[r] = mt; BT[r] = A; }
            if (lane == 31) p.out[O_SM + sid] = mt;
        }
    }
    __syncthreads();
}
template <int NKT> struct AtPre { u32x4 kr[(NKT * 128 + 511) / 512], vr[(NKT * 128 + 511) / 512]; };
template <int NKT, bool SAMPLE>
DI void attn_load(const Params& p, LAS unsigned char* lds, int r, AtPre<NKT>& R) {
    const int tid = opaque_tid();
    const int n = SAMPLE ? (r >> 1) : (r >> 8), c = SAMPLE ? 0 : ((r >> 1) & 127), kv = r & 1;
    const bf16_t* zKA = (const bf16_t*)(p.ws + WS_ZA + ZA_KA); const bf16_t* zVA = (const bf16_t*)(p.ws + WS_ZA + ZA_VA);
    constexpr int NP = (NKT * 128 + 511) / 512;
#pragma unroll
    for (int i = 0; i < NP; ++i) {
        const int idx = tid + 512 * i; const int row = idx >> 3, ch = idx & 7;
        u32x4 kk = {0u, 0u, 0u, 0u}, vv = kk;
        if (idx < NKT * 128) {
            if (!SAMPLE) {
                const int kpos = (c - 2) * 64 + row;
                if (kpos >= 0) { const size_t o = ((size_t)kv * M + (size_t)n * SEQ + kpos) * 64 + ch * 8; kk = *(const u32x4*)(zKA + o); vv = *(const u32x4*)(zVA + o); }
            } else {
                if (row < 128) {
                    const float* ck = PIN(2) + ((size_t)(n * 128 + row) * 2 + kv) * 64 + ch * 8; const float* cv = PIN(3) + ((size_t)(n * 128 + row) * 2 + kv) * 64 + ch * 8;
                    const f32x4 k0 = *(const f32x4*)ck, k1 = *(const f32x4*)(ck + 4), v0 = *(const f32x4*)cv, v1 = *(const f32x4*)(cv + 4);
                    kk.x = cvtpk(k0[0], k0[1]); kk.y = cvtpk(k0[2], k0[3]); kk.z = cvtpk(k1[0], k1[1]); kk.w = cvtpk(k1[2], k1[3]);
                    vv.x = cvtpk(v0[0], v0[1]); vv.y = cvtpk(v0[2], v0[3]); vv.z = cvtpk(v1[0], v1[1]); vv.w = cvtpk(v1[2], v1[3]);
                } else { const size_t o = ((size_t)kv * M + (size_t)MP + n * DSEQ + row - 128) * 64 + ch * 8; kk = *(const u32x4*)(zKA + o); vv = *(const u32x4*)(zVA + o); }
            }
        }
        R.kr[i] = kk; R.vr[i] = vv;
    }
}
template <int NKT, int NQB, bool SAMPLE>
DI void attn_item(const Params& p, LAS unsigned char* lds, int r, AtPre<NKT>& R, int next_r) {
    const int tid = opaque_tid(), lane = tid & 63, g = __builtin_amdgcn_readfirstlane(tid >> 6), fr = lane & 15, fq = lane >> 4;
    const int n = SAMPLE ? (r >> 1) : (r >> 8), c = SAMPLE ? 0 : ((r >> 1) & 127), kv = r & 1;
    const bf16_t* zA = (const bf16_t*)(p.ws + WS_ZA);
    bf16_t* ya = (bf16_t*)((unsigned char*)p.out + OY_YA);
    LAS unsigned char* Kimg = lds; LAS unsigned char* Vimg = lds + 192 * 144;
    constexpr int NP = (NKT * 128 + 511) / 512;
    __syncthreads();
#pragma unroll
    for (int i = 0; i < NP; ++i) {
        const int idx = tid + 512 * i; const int row = idx >> 3, ch = idx & 7;
        if (idx < NKT * 128) { *(LAS u32x4*)(Kimg + row * 144 + ch * 16) = R.kr[i]; *(LAS u32x4*)(Vimg + row * 144 + ch * 16) = R.vr[i]; }
    }
    __syncthreads();
    if (next_r >= 0) attn_load<NKT, SAMPLE>(p, lds, next_r, R);
    const int hq = kv * 8 + g;
    const float slope2 = exp2f(-0.5f * (float)(hq + 1)) * 1.4426950408889634f, sink2 = PIN(15)[hq] * 1.4426950408889634f;
    constexpr float scale2 = 0.125f * 1.4426950408889634f;
    const size_t rowbase = SAMPLE ? (size_t)MP + n * DSEQ : (size_t)n * SEQ + c * 64;
    const int kmin = SAMPLE ? 0 : (c >= 2 ? 0 : (2 - c) * 64);
    bf16x8 Qf[2];
#pragma unroll
    for (int ks = 0; ks < 2; ++ks) Qf[ks] = ntl((const bf16x8*)(zA + (rowbase + fr) * 1024 + hq * 64 + ks * 32 + fq * 8));
#pragma unroll 1
    for (int qb = 0; qb < NQB; ++qb) {
        const size_t qrow = rowbase + qb * 16 + fr;
        bf16x8 Qn[2];
        { const size_t qnext = qrow + (qb + 1 < NQB ? 16 : 0);
#pragma unroll
          for (int ks = 0; ks < 2; ++ks) Qn[ks] = ntl((const bf16x8*)(zA + qnext * 1024 + hq * 64 + ks * 32 + fq * 8)); }
        f32x4 s[NKT];
#pragma unroll
        for (int kt = 0; kt < NKT; ++kt) {
            s[kt] = (f32x4){0.f, 0.f, 0.f, 0.f};
#pragma unroll
            for (int ks = 0; ks < 2; ++ks) { const bf16x8 A = *(const LAS bf16x8*)(Kimg + (kt * 16 + fr) * 144 + (ks * 32 + fq * 8) * 2); s[kt] = MFMA16(A, Qf[ks], s[kt]); }
        }
        const float fb = (float)(128 + qb * 16 + fr - fq * 4);
#pragma unroll
        for (int kt = 0; kt < NKT; ++kt)
#pragma unroll
            for (int j = 0; j < 4; ++j) { const float t = fb - (float)(kt * 16 + j); s[kt][j] = fmaf(s[kt][j], scale2, -(slope2 * fabsf(t))); }
        if (kmin > 0) {
#pragma unroll
            for (int kt = 0; kt < NKT; ++kt)
#pragma unroll
                for (int j = 0; j < 4; ++j) { const int key = kt * 16 + fq * 4 + j; s[kt][j] = key >= kmin ? s[kt][j] : -1e30f; }
        }
        float mx = sink2;
#pragma unroll
        for (int kt = 0; kt < NKT; ++kt) mx = fmaxf(fmaxf(mx, fmaxf(s[kt][0], s[kt][1])), fmaxf(s[kt][2], s[kt][3]));
        mx = fmaxf(mx, __shfl_xor(mx, 16)); mx = fmaxf(mx, __shfl_xor(mx, 32));
        float sum = 0.f;
#pragma unroll
        for (int kt = 0; kt < NKT; ++kt)
#pragma unroll
            for (int j = 0; j < 4; ++j) { const float e = __builtin_amdgcn_exp2f(s[kt][j] - mx); s[kt][j] = e; sum += e; }
        sum += __shfl_xor(sum, 16); sum += __shfl_xor(sum, 32);
        const float inv = __builtin_amdgcn_rcpf(sum + __builtin_amdgcn_exp2f(sink2 - mx));
        f32x4 o[4];
#pragma unroll
        for (int dt = 0; dt < 4; ++dt) o[dt] = (f32x4){0.f, 0.f, 0.f, 0.f};
#pragma unroll
        for (int kk = 0; kk < NKT / 2; ++kk) {
            u32x4 pw; pw.x = cvtpk(s[2 * kk][0], s[2 * kk][1]); pw.y = cvtpk(s[2 * kk][2], s[2 * kk][3]); pw.z = cvtpk(s[2 * kk + 1][0], s[2 * kk + 1][1]); pw.w = cvtpk(s[2 * kk + 1][2], s[2 * kk + 1][3]);
            const bf16x8 Pf = __builtin_bit_cast(bf16x8, pw);
#pragma unroll
            for (int dt = 0; dt < 4; ++dt) {
                const LAS unsigned char* vp = Vimg + ((2 * kk) * 16 + fq * 4 + (fr >> 2)) * 144 + (dt * 16 + 4 * (fr & 3)) * 2;
                const bf16x8 A = cat8(lds_tr(vp), lds_tr(vp + 16 * 144));
                o[dt] = MFMA16(A, Pf, o[dt]);
            }
        }
#pragma unroll
        for (int dt = 0; dt < 4; dt += 2) { u32x4 w; w.x = cvtpk(o[dt][0] * inv, o[dt][1] * inv); w.y = cvtpk(o[dt][2] * inv, o[dt][3] * inv);
            w.z = cvtpk(o[dt + 1][0] * inv, o[dt + 1][1] * inv); w.w = cvtpk(o[dt + 1][2] * inv, o[dt + 1][3] * inv);
            swap16x2(w);
            *(u32x4*)(ya + qrow * 1024 + hq * 64 + dt * 16 + ((fq & 1) * 16) + ((fq >> 1) * 8)) = w; }
        Qf[0] = Qn[0]; Qf[1] = Qn[1];
    }
}
struct DcPre { u32x4 kr[4], vr[8]; float wkv, Bend, mend; };
template <bool SAMPLE>
DI void dc_load(const Params& p, LAS unsigned char* lds, int r, DcPre& R) {
    const int tid = opaque_tid();
    const int n = SAMPLE ? (r >> 2) : (r >> 8), hh = SAMPLE ? (r & 3) : ((r >> 6) & 3), cc = SAMPLE ? 0 : (r & 63);
    const bf16_t* zB = (const bf16_t*)(p.ws + WS_ZB);
    const float* GI = (const float*)(p.ws + WS_GI); const float* MT = (const float*)(p.ws + WS_MT); const float* BT = (const float*)(p.ws + WS_BT);
    const size_t row0 = SAMPLE ? (size_t)MP + n * DSEQ : (size_t)n * SEQ + cc * 128;
    constexpr int tv = SAMPLE ? DSEQ : 128;
    const size_t rlast = (row0 + tv - 1) * 4 + hh;
    R.Bend = BT[rlast]; R.mend = MT[rlast];
#pragma unroll
    for (int i = 0; i < 4; ++i) { const int idx = tid + 512 * i; const int row = idx >> 4, ch = idx & 15;
        R.kr[i] = (u32x4){0u, 0u, 0u, 0u};
        if (row < tv) R.kr[i] = *(const u32x4*)(zB + ZB_KM / 2 + ((size_t)hh * M + row0 + row) * 128 + ch * 8); }
#pragma unroll
    for (int i = 0; i < 8; ++i) { const int idx = tid + 512 * i; const int row = idx >> 5, ch = idx & 31;
        R.vr[i] = (u32x4){0u, 0u, 0u, 0u};
        if (row < tv) R.vr[i] = *(const u32x4*)(zB + ZB_VM / 2 + ((size_t)hh * M + row0 + row) * 256 + ch * 8); }
    R.wkv = 0.f;
    if (tid < tv) { const size_t rr = (row0 + tid) * 4 + hh; R.wkv = __expf(R.Bend - BT[rr] + GI[rr] - R.mend); }
}
template <bool SAMPLE>
DI void dc_item(const Params& p, LAS unsigned char* lds, int r, DcPre& R, int next_r) {
    constexpr bool sample = SAMPLE;
    const int tid = opaque_tid(), lane = tid & 63, w = __builtin_amdgcn_readfirstlane(tid >> 6), fr = lane & 15, fq = lane >> 4;
    const int n = SAMPLE ? (r >> 2) : (r >> 8), hh = SAMPLE ? (r & 3) : ((r >> 6) & 3), cc = SAMPLE ? 0 : (r & 63);
    LAS unsigned char* KW = lds; LAS unsigned char* Vimg = lds + 128 * 272; LAS float* wk = (LAS float*)(lds + 128 * 272 + 128 * 528);
    constexpr int nks = sample ? 1 : 4;
    const float Bend = R.Bend, mend = R.mend;
    __syncthreads();
    if (tid < 128) wk[tid] = R.wkv;
#pragma unroll
    for (int i = 0; i < 8; ++i) { const int idx = tid + 512 * i; const int row = idx >> 5, ch = idx & 31;
        if (row < nks * 32) *(LAS u32x4*)(Vimg + row * 528 + ch * 16) = R.vr[i]; }
    __syncthreads();
#pragma unroll
    for (int i = 0; i < 4; ++i) { const int idx = tid + 512 * i; const int row = idx >> 4, ch = idx & 15;
        if (row < nks * 32) { const float wv = wk[row]; const u32x4 k = R.kr[i];
            u32x4 o; o.x = cvtpk(bflo(k.x) * wv, bfhi(k.x) * wv); o.y = cvtpk(bflo(k.y) * wv, bfhi(k.y) * wv); o.z = cvtpk(bflo(k.z) * wv, bfhi(k.z) * wv); o.w = cvtpk(bflo(k.w) * wv, bfhi(k.w) * wv);
            *(LAS u32x4*)(KW + row * 272 + ch * 16) = o; } }
    __syncthreads();
    if (next_r >= 0) dc_load<SAMPLE>(p, lds, next_r, R);
    f32x4 acc[8][2];
#pragma unroll
    for (int mt = 0; mt < 8; ++mt) { acc[mt][0] = (f32x4){0.f, 0.f, 0.f, 0.f}; acc[mt][1] = acc[mt][0]; }
    for (int ks = 0; ks < nks; ++ks) {
        const int lrow = ks * 32 + fq * 8 + (fr >> 2);
        bf16x8 Bf[2];
#pragma unroll
        for (int nt = 0; nt < 2; ++nt) { const LAS unsigned char* vp = Vimg + lrow * 528 + ((2 * w + nt) * 16 + 4 * (fr & 3)) * 2; Bf[nt] = cat8(lds_tr(vp), lds_tr(vp + 4 * 528)); }
#pragma unroll
        for (int mt = 0; mt < 8; ++mt) {
            const LAS unsigned char* kp = KW + lrow * 272 + (mt * 16 + 4 * (fr & 3)) * 2;
            const bf16x8 Af = cat8(lds_tr(kp), lds_tr(kp + 4 * 272));
            acc[mt][0] = MFMA16(Af, Bf[0], acc[mt][0]); acc[mt][1] = MFMA16(Af, Bf[1], acc[mt][1]);
        }
    }
    const int chain = n * 4 + hh;
    if (!sample) {
        bf16_t* CS = (bf16_t*)(p.ws + WS_CS) + ((size_t)(chain * 64 + cc)) * 32768;
        const int wide = ((fq & 1) * 16) + ((fq >> 1) * 8);
#pragma unroll
        for (int mt = 0; mt < 8; mt += 2)
#pragma unroll
            for (int nt = 0; nt < 2; ++nt) { const int dv = (2 * w + nt) * 16 + fr;
                u32x4 o; o.x = cvtpk(acc[mt][nt][0], acc[mt][nt][1]); o.y = cvtpk(acc[mt][nt][2], acc[mt][nt][3]);
                o.z = cvtpk(acc[mt + 1][nt][0], acc[mt + 1][nt][1]); o.w = cvtpk(acc[mt + 1][nt][2], acc[mt + 1][nt][3]);
                swap16x2(o);
                *(u32x4*)(CS + dv * 128 + mt * 16 + wide) = o; }
        if (tid < 128) { float s = 0.f; for (int l = 0; l < 128; ++l) s += __uint_as_float((unsigned)(*(const LAS unsigned short*)(KW + l * 272 + tid * 2)) << 16);
            ((float*)(p.ws + WS_CSN))[(size_t)(chain * 64 + cc) * 128 + tid] = s; }
    } else {
        const float decay = __expf(Bend + PIN(6)[chain] - mend);
        const float* C0 = PIN(4) + (size_t)chain * 32768; float* Co = p.out + O_SC + (size_t)chain * 32768;
#pragma unroll
        for (int mt = 0; mt < 8; ++mt)
#pragma unroll
            for (int nt = 0; nt < 2; ++nt) { const int dv = (2 * w + nt) * 16 + fr, dq = mt * 16 + fq * 4;
                const f32x4 c0 = *(const f32x4*)(C0 + dv * 128 + dq);
                *(f32x4*)(Co + dv * 128 + dq) = c0 * decay + acc[mt][nt]; }
        if (tid < 128) { float s = 0.f; for (int l = 0; l < DSEQ; ++l) s += __uint_as_float((unsigned)(*(const LAS unsigned short*)(KW + l * 272 + tid * 2)) << 16);
            p.out[O_SN + (size_t)chain * 128 + tid] = decay * PIN(5)[(size_t)chain * 128 + tid] + s; }
    }
}
DI void phase2_dc(const Params& p, LAS unsigned char* lds) {
    const int G = gridDim.x, b0 = blockIdx.x;
    DcPre R;
    { int r = b0; if (r < 1024) dc_load<false>(p, lds, r, R);
      for (; r < 1024; r += G) { const int nx = r + G; dc_item<false>(p, lds, r, R, nx < 1024 ? nx : -1); } }
    { int r = b0; if (r < 128) dc_load<true>(p, lds, r, R);
      for (; r < 128; r += G) { const int nx = r + G; dc_item<true>(p, lds, r, R, nx < 128 ? nx : -1); } }
}
DI void phase2_at(const Params& p, LAS unsigned char* lds) {
    const int G = gridDim.x, b0 = blockIdx.x;
    { AtPre<12> R; int r = b0; if (r < 1024) attn_load<12, false>(p, lds, r, R);
      for (; r < 1024; r += G) { const int nx = r + G; attn_item<12, 4, false>(p, lds, r, R, nx < 1024 ? nx : -1); } }
    { AtPre<10> R; int r = G - 1 - b0;
      if (r < 64) attn_load<10, true>(p, lds, r, R);
      for (; r < 64; r += G) { const int nx = r + G; attn_item<10, 2, true>(p, lds, r, R, nx < 64 ? nx : -1); } }
}
DI void phase2(const Params& p, LAS unsigned char* lds) {
    if (((blockIdx.x >> 3) & 1) == 0) { phase2_dc(p, lds); phase2_at(p, lds); }
    else { phase2_at(p, lds); phase2_dc(p, lds); }
}
DI void phase3(const Params& p, LAS unsigned char* lds) {
    const int tid = opaque_tid();
    LAS float* dec = (LAS float*)lds;
    const float* MT = (const float*)(p.ws + WS_MT); const float* BT = (const float*)(p.ws + WS_BT);
    for (int g0 = blockIdx.x * 256; g0 < 16 * 4096; g0 += gridDim.x * 256) {
        const int chain = g0 >> 12, n = chain >> 2, hh = chain & 3;
        __syncthreads();
        if (tid < 64) { const size_t rl = ((size_t)n * SEQ + tid * 128 + 127) * 4 + hh;
            const float mprev = tid > 0 ? MT[rl - 512] : 0.f; dec[tid] = __expf(BT[rl] + mprev - MT[rl]); }
        __syncthreads();
        if (tid < 256) {
            const int e8 = (g0 + tid) & 4095;
            bf16_t* ptr = (bf16_t*)(p.ws + WS_CS) + (size_t)chain * 64 * 32768 + e8 * 8;
            f32x4 ra = {0.f, 0.f, 0.f, 0.f}, rb = ra;
#pragma unroll 8
            for (int c = 0; c < 64; ++c) {
                const u32x4 d = ntl((const u32x4*)(ptr + (size_t)c * 32768));
                u32x4 o; o.x = cvtpk(ra[0], ra[1]); o.y = cvtpk(ra[2], ra[3]); o.z = cvtpk(rb[0], rb[1]); o.w = cvtpk(rb[2], rb[3]);
                *(u32x4*)(ptr + (size_t)c * 32768) = o;
                const float dc = dec[c];
                ra[0] = ra[0] * dc + bflo(d.x); ra[1] = ra[1] * dc + bfhi(d.x); ra[2] = ra[2] * dc + bflo(d.y); ra[3] = ra[3] * dc + bfhi(d.y);
                rb[0] = rb[0] * dc + bflo(d.z); rb[1] = rb[1] * dc + bfhi(d.z); rb[2] = rb[2] * dc + bflo(d.w); rb[3] = rb[3] * dc + bfhi(d.w);
            }
            float* op = p.out + O_PC + (size_t)chain * 32768 + e8 * 8;
            *(f32x4*)op = ra; *(f32x4*)(op + 4) = rb;
            if (e8 < 128) {
                float* np = (float*)(p.ws + WS_CSN) + (size_t)chain * 64 * 128 + e8; float rn = 0.f;
                for (int c = 0; c < 64; ++c) { const float d = np[c * 128]; np[c * 128] = rn; rn = rn * dec[c] + d; }
                p.out[O_PN + chain * 128 + e8] = rn;
            }
        }
    }
}
struct MoutPre { u32x4 qr[4], kr[4], cr[8]; float nvv, biv, mstart, bl, mtl; };
template <bool SAMPLE>
DI void mout_load(const Params& p, LAS unsigned char* lds, int it, MoutPre& R) {
    const int tid = opaque_tid(), lane = tid & 63, w = __builtin_amdgcn_readfirstlane(tid >> 6), fr = lane & 15;
    constexpr bool sample = SAMPLE;
    const int r_ = it - 1024;
    const int n = sample ? (r_ >> 2) : (it >> 8), hh = sample ? (r_ & 3) : ((it >> 6) & 3), cc = sample ? 0 : (it & 63);
    const bf16_t* zB = (const bf16_t*)(p.ws + WS_ZB);
    const float* GI = (const float*)(p.ws + WS_GI); const float* MT = (const float*)(p.ws + WS_MT); const float* BT = (const float*)(p.ws + WS_BT);
    const size_t row0 = sample ? (size_t)MP + n * DSEQ : (size_t)n * SEQ + cc * 128;
    constexpr int tv = sample ? DSEQ : 128;
    const int chain = n * 4 + hh;
#pragma unroll
    for (int i = 0; i < 4; ++i) { const int idx = tid + 512 * i; const int row = idx >> 4, ch = idx & 15;
        R.qr[i] = (u32x4){0u, 0u, 0u, 0u}; R.kr[i] = R.qr[i];
        if (row < tv) { const bf16_t* src = zB + ((size_t)hh * M + row0 + row) * 128 + ch * 8; R.qr[i] = ntl((const u32x4*)src); R.kr[i] = ntl((const u32x4*)(src + ZB_KM / 2)); } }
    if (!sample) {
        const bf16_t* CS = (const bf16_t*)(p.ws + WS_CS) + ((size_t)(chain * 64 + cc)) * 32768;
#pragma unroll
        for (int i = 0; i < 8; ++i) { const int idx = tid + 512 * i; const int row = idx >> 4, ch = idx & 15; R.cr[i] = ntl((const u32x4*)(CS + row * 128 + ch * 8)); }
    } else {
        const float* C0 = PIN(4) + (size_t)chain * 32768;
#pragma unroll
        for (int i = 0; i < 8; ++i) { const int idx = tid + 512 * i; const int row = idx >> 4, ch = idx & 15;
            const f32x4 a = *(const f32x4*)(C0 + row * 128 + ch * 8), b = *(const f32x4*)(C0 + row * 128 + ch * 8 + 4);
            u32x4 o; o.x = cvtpk(a[0], a[1]); o.y = cvtpk(a[2], a[3]); o.z = cvtpk(b[0], b[1]); o.w = cvtpk(b[2], b[3]); R.cr[i] = o; }
    }
    R.nvv = 0.f; R.biv = 0.f;
    if (tid < 128) {
        R.nvv = sample ? PIN(5)[(size_t)chain * 128 + tid] : ((const float*)(p.ws + WS_CSN))[(size_t)(chain * 64 + cc) * 128 + tid];
        if (tid < tv) { const size_t r = (row0 + tid) * 4 + hh; R.biv = GI[r] - BT[r]; }
    }
    R.mstart = sample ? PIN(6)[chain] : (cc > 0 ? MT[(row0 - 1) * 4 + hh] : 0.f);
    const size_t row = row0 + w * 16 + fr;
    R.bl = 0.f; R.mtl = 0.f;
    if (w * 16 < tv) { R.bl = BT[row * 4 + hh]; R.mtl = MT[row * 4 + hh]; }
}
template <bool SAMPLE>
DI void mout_item(const Params& p, LAS unsigned char* lds, int it, MoutPre& R, int next_it) {
    const int tid = opaque_tid(), lane = tid & 63, w = __builtin_amdgcn_readfirstlane(tid >> 6), fr = lane & 15, fq = lane >> 4;
    constexpr bool sample = SAMPLE;
    const int r_ = it - 1024;
    const int n = sample ? (r_ >> 2) : (it >> 8), hh = sample ? (r_ & 3) : ((it >> 6) & 3), cc = sample ? 0 : (it & 63);
    const bf16_t* zB = (const bf16_t*)(p.ws + WS_ZB); const bf16_t* zG = (const bf16_t*)(p.ws + WS_ZG);
    bf16_t* yb = (bf16_t*)((unsigned char*)p.out + OY_YB);
    LAS unsigned char* Qimg = lds; LAS unsigned char* Kimg = lds + 34816; LAS unsigned char* CV = lds + 69632;
    LAS float* bi = (LAS float*)(lds + 139264); LAS float* nv = bi + 128;
    const size_t row0 = sample ? (size_t)MP + n * DSEQ : (size_t)n * SEQ + cc * 128;
    constexpr int tv = sample ? DSEQ : 128;
    const bool active = w * 16 < tv;
    const size_t row = row0 + w * 16 + fr;
    const float mstart = R.mstart, bl = R.bl, mtl = R.mtl;
    __syncthreads();
#pragma unroll
    for (int i = 0; i < 4; ++i) { const int idx = tid + 512 * i; const int r = idx >> 4, ch = idx & 15;
        *(LAS u32x4*)(Qimg + r * 272 + ch * 16) = R.qr[i]; *(LAS u32x4*)(Kimg + r * 272 + ch * 16) = R.kr[i]; }
#pragma unroll
    for (int i = 0; i < 8; ++i) { const int idx = tid + 512 * i; const int r = idx >> 4, ch = idx & 15; *(LAS u32x4*)(CV + r * 272 + ch * 16) = R.cr[i]; }
    if (tid < 128) { nv[tid] = R.nvv; bi[tid] = R.biv; }
    u32x4 vr[8];
#pragma unroll
    for (int i = 0; i < 8; ++i) { const int idx = tid + 512 * i; const int r = idx >> 5, ch = idx & 31;
        vr[i] = (u32x4){0u, 0u, 0u, 0u};
        if (r < tv) vr[i] = ntl((const u32x4*)(zB + ZB_VM / 2 + ((size_t)hh * M + row0 + r) * 256 + ch * 8)); }
    __syncthreads();
    f32x4 acc[16];
    bf16x8 Pf[4];
    float den = 0.f;
    if (active) {
        const float gsc = __expf(bl + mstart - mtl);
        bf16x8 Qf[4];
#pragma unroll
        for (int ks = 0; ks < 4; ++ks) Qf[ks] = *(const LAS bf16x8*)(Qimg + (w * 16 + fr) * 272 + (ks * 32 + fq * 8) * 2);
        float qn = 0.f;
#pragma unroll
        for (int ks = 0; ks < 4; ++ks) {
            const f32x4 n0 = *(const LAS f32x4*)(nv + ks * 32 + fq * 8), n1 = *(const LAS f32x4*)(nv + ks * 32 + fq * 8 + 4);
            const u32x4 qq = __builtin_bit_cast(u32x4, Qf[ks]);
            qn += bflo(qq.x) * n0[0] + bfhi(qq.x) * n0[1] + bflo(qq.y) * n0[2] + bfhi(qq.y) * n0[3] + bflo(qq.z) * n1[0] + bfhi(qq.z) * n1[1] + bflo(qq.w) * n1[2] + bfhi(qq.w) * n1[3];
        }
        qn += __shfl_xor(qn, 16); qn += __shfl_xor(qn, 32);
        den = gsc * qn;
        f32x4 s[8];
        float dsum = 0.f;
        const float blm = bl - mtl;
        const int lidx = w * 16 + fr;
#pragma unroll
        for (int kt = 0; kt < 8; ++kt) {
            s[kt] = (f32x4){0.f, 0.f, 0.f, 0.f};
            if (kt <= w) {
#pragma unroll
                for (int ks = 0; ks < 4; ++ks) { const bf16x8 A = *(const LAS bf16x8*)(Kimg + (kt * 16 + fr) * 272 + (ks * 32 + fq * 8) * 2); s[kt] = MFMA16(A, Qf[ks], s[kt]); }
                const f32x4 bv = *(const LAS f32x4*)(bi + kt * 16 + fq * 4);
#pragma unroll
                for (int j = 0; j < 4; ++j) { const int key = kt * 16 + fq * 4 + j; const float pv = key <= lidx ? s[kt][j] * __expf(blm + bv[j]) : 0.f; s[kt][j] = pv; dsum += pv; }
            }
        }
        dsum += __shfl_xor(dsum, 16); dsum += __shfl_xor(dsum, 32);
        den += dsum;
#pragma unroll
        for (int kk = 0; kk < 4; ++kk) { u32x4 pw; pw.x = cvtpk(s[2 * kk][0], s[2 * kk][1]); pw.y = cvtpk(s[2 * kk][2], s[2 * kk][3]); pw.z = cvtpk(s[2 * kk + 1][0], s[2 * kk + 1][1]); pw.w = cvtpk(s[2 * kk + 1][2], s[2 * kk + 1][3]);
            Pf[kk] = __builtin_bit_cast(bf16x8, pw); }
#pragma unroll
        for (int mt = 0; mt < 16; ++mt) {
            acc[mt] = (f32x4){0.f, 0.f, 0.f, 0.f};
#pragma unroll
            for (int ks = 0; ks < 4; ++ks) { const bf16x8 A = *(const LAS bf16x8*)(CV + (mt * 16 + fr) * 272 + (ks * 32 + fq * 8) * 2); acc[mt] = MFMA16(A, Qf[ks], acc[mt]); }
            acc[mt] = acc[mt] * gsc;
            if (mt & 1) __builtin_amdgcn_sched_barrier(0);
        }
    }
    __syncthreads();
#pragma unroll
    for (int i = 0; i < 8; ++i) { const int idx = tid + 512 * i; const int r = idx >> 5, ch = idx & 31; *(LAS u32x4*)(CV + r * 528 + ch * 16) = vr[i]; }
    __syncthreads();
    if (next_it >= 0) mout_load<SAMPLE>(p, lds, next_it, R);
    if (active) {
#pragma unroll
        for (int mt = 0; mt < 16; ++mt)
#pragma unroll
            for (int kk = 0; kk < 4; ++kk)
                if (2 * kk <= w) {
                    const LAS unsigned char* vp = CV + ((2 * kk) * 16 + fq * 4 + (fr >> 2)) * 528 + (mt * 16 + 4 * (fr & 3)) * 2;
                    const bf16x8 A = cat8(lds_tr(vp), lds_tr(vp + 16 * 528));
                    acc[mt] = MFMA16(A, Pf[kk], acc[mt]);
                    if (kk == 3) __builtin_amdgcn_sched_barrier(0);
                }
        const float inv = 1.f / fmaxf(fabsf(den), __expf(-mtl));
        float sm = 0.f;
#pragma unroll
        for (int mt = 0; mt < 16; ++mt) { acc[mt] = acc[mt] * inv; sm += (acc[mt][0] + acc[mt][1]) + (acc[mt][2] + acc[mt][3]); }
        sm += __shfl_xor(sm, 16); sm += __shfl_xor(sm, 32);
        const float mean = sm * (1.f / 256.f);
        float sv = 0.f;
#pragma unroll
        for (int mt = 0; mt < 16; ++mt) { acc[mt] = acc[mt] - mean; sv += (acc[mt][0] * acc[mt][0] + acc[mt][1] * acc[mt][1]) + (acc[mt][2] * acc[mt][2] + acc[mt][3] * acc[mt][3]); }
        sv += __shfl_xor(sv, 16); sv += __shfl_xor(sv, 32);
        const float rstd = 1.f / sqrtf(sv * (1.f / 256.f) + LN_EPS);
        const float* nw = PIN(16) + hh * 256;
        const int wide = ((fq & 1) * 16) + ((fq >> 1) * 8);
#pragma unroll
        for (int mt = 0; mt < 16; mt += 2) {
            const int dv = mt * 16 + fq * 4;
            const f32x4 wa = *(const f32x4*)(nw + dv), wb = *(const f32x4*)(nw + dv + 16);
            u32x4 og = ntl((const u32x4*)(zG + ((size_t)hh * M + row) * 256 + mt * 16 + wide));
            swap16x2(og);
            u32x4 o;
            o.x = cvtpk(acc[mt][0] * rstd * wa[0] * bflo(og.x), acc[mt][1] * rstd * wa[1] * bfhi(og.x));
            o.y = cvtpk(acc[mt][2] * rstd * wa[2] * bflo(og.y), acc[mt][3] * rstd * wa[3] * bfhi(og.y));
            o.z = cvtpk(acc[mt + 1][0] * rstd * wb[0] * bflo(og.z), acc[mt + 1][1] * rstd * wb[1] * bfhi(og.z));
            o.w = cvtpk(acc[mt + 1][2] * rstd * wb[2] * bflo(og.w), acc[mt + 1][3] * rstd * wb[3] * bfhi(og.w));
            swap16x2(o);
            *(u32x4*)(yb + row * 1024 + hh * 256 + mt * 16 + wide) = o;
        }
    }
}
DI void phase4(const Params& p, LAS unsigned char* lds) {
    const int G = gridDim.x;
    MoutPre R;
    { int it = blockIdx.x;
      if (it < 1024) mout_load<false>(p, lds, it, R);
      for (; it < 1024; it += G) { const int nx = it + G; mout_item<false>(p, lds, it, R, nx < 1024 ? nx : -1); } }
    { int it = 1024 + blockIdx.x;
      if (it < 1152) mout_load<true>(p, lds, it, R);
      for (; it < 1152; it += G) { const int nx = it + G; mout_item<true>(p, lds, it, R, nx < 1152 ? nx : -1); } }
}
template <bool FIRST>
DI void ln_rows(const Params& p, LAS unsigned char* lds) {
    const int tid = opaque_tid(), lane = tid & 63, wave = tid >> 6;
    const bf16_t* rbuf = (const bf16_t*)(p.ws + (FIRST ? WS_R1 : WS_R2));
    const float* lw = FIRST ? PIN(20) : PIN(27); const float* lb = FIRST ? PIN(21) : PIN(28);
    const float* mod = (const float*)(p.ws + WS_MOD);
    bf16_t* h2 = (bf16_t*)((unsigned char*)p.out + OY_H2);
    bf16_t* x1h = (bf16_t*)(p.ws + WS_X1);
    const float* xp0 = PIN(0); const float* xs0 = PIN(1);
    for (int rg = blockIdx.x * 8 + wave; rg < M / 4; rg += gridDim.x * 8) {
        f32x4 v[4][4]; float s[4], s2[4];
#pragma unroll
        for (int q = 0; q < 4; ++q) { const int rr = rg * 4 + q; const bf16_t* rp = rbuf + (size_t)rr * D; s[q] = 0.f;
#pragma unroll
            for (int i = 0; i < 2; ++i) { const int c = 8 * lane + 512 * i;
                const u32x4 rv = ntl((const u32x4*)(rp + c));
                const f32x4 ra = {bflo(rv.x), bfhi(rv.x), bflo(rv.y), bfhi(rv.y)}, rb = {bflo(rv.z), bfhi(rv.z), bflo(rv.w), bfhi(rv.w)};
                f32x4 xa, xb;
                if (FIRST) { const float* xr = xrow_of(xp0, xs0, rr) + c; xa = ntl((const f32x4*)xr); xb = ntl((const f32x4*)(xr + 4)); }
                else { const u32x4 xv = ntl((const u32x4*)(x1h + (size_t)rr * D + c)); xa = (f32x4){bflo(xv.x), bfhi(xv.x), bflo(xv.y), bfhi(xv.y)}; xb = (f32x4){bflo(xv.z), bfhi(xv.z), bflo(xv.w), bfhi(xv.w)}; }
                v[q][2 * i] = ra + xa * ALPHA; v[q][2 * i + 1] = rb + xb * ALPHA;
                s[q] += ((v[q][2 * i][0] + v[q][2 * i][1]) + (v[q][2 * i][2] + v[q][2 * i][3])) + ((v[q][2 * i + 1][0] + v[q][2 * i + 1][1]) + (v[q][2 * i + 1][2] + v[q][2 * i + 1][3])); } }
#pragma unroll
        for (int q = 0; q < 4; ++q) s[q] = wave_sum(s[q]) * (1.f / D);
#pragma unroll
        for (int q = 0; q < 4; ++q) { s2[q] = 0.f;
#pragma unroll
            for (int i = 0; i < 4; ++i) { v[q][i] = v[q][i] - s[q]; s2[q] += (v[q][i][0] * v[q][i][0] + v[q][i][1] * v[q][i][1]) + (v[q][i][2] * v[q][i][2] + v[q][i][3] * v[q][i][3]); } }
#pragma unroll
        for (int q = 0; q < 4; ++q) s2[q] = 1.f / sqrtf(wave_sum(s2[q]) * (1.f / D) + LN_EPS);
#pragma unroll
        for (int q = 0; q < 4; ++q) {
            const int row = rg * 4 + q;
            const float* mr = mod + (size_t)crow_of(row) * 6144;
#pragma unroll
            for (int i = 0; i < 2; ++i) {
                const int c = 8 * lane + 512 * i;
                const f32x4 ya = v[q][2 * i] * s2[q] * *(const f32x4*)(lw + c) + *(const f32x4*)(lb + c);
                const f32x4 yb = v[q][2 * i + 1] * s2[q] * *(const f32x4*)(lw + c + 4) + *(const f32x4*)(lb + c + 4);
                if (FIRST) {
                    u32x4 xw; xw.x = cvtpk(ya[0], ya[1]); xw.y = cvtpk(ya[2], ya[3]); xw.z = cvtpk(yb[0], yb[1]); xw.w = cvtpk(yb[2], yb[3]);
                    *(u32x4*)(x1h + (size_t)row * D + c) = xw;
                    const f32x4 ha = ya * (*(const f32x4*)(mr + 4096 + c) + 1.f) + *(const f32x4*)(mr + 3072 + c);
                    const f32x4 hb = yb * (*(const f32x4*)(mr + 4096 + c + 4) + 1.f) + *(const f32x4*)(mr + 3072 + c + 4);
                    u32x4 w; w.x = cvtpk(ha[0], ha[1]); w.y = cvtpk(ha[2], ha[3]); w.z = cvtpk(hb[0], hb[1]); w.w = cvtpk(hb[2], hb[3]);
                    *(u32x4*)(h2 + (size_t)row * D + c) = w;
                } else { float* yp = p.out + O_Y + (size_t)row * D + c; nts((f32x4*)yp, ya); nts((f32x4*)(yp + 4), yb); }
            }
        }
    }
}
DI void phase7(const Params& p, LAS unsigned char* lds) {
    const int tid = opaque_tid(), lane = tid & 63, wave = tid >> 6;
    LAS float* scr = (LAS float*)(lds + wave * 8448);
    constexpr int I_UP = 16 * 176, I_DN = 44 * 32;
    const float* w_up = PIN(22); const float* w_dn = PIN(26);
    for (int it = blockIdx.x * 8 + wave; it < I_UP + I_DN; it += gridDim.x * 8) {
        if (it < I_UP) { const int kb = it / 176, nb = it - kb * 176; const int n0 = nb * 32; const int pn = n0 >> 8, wi = n0 & 255;
            wtrans_item(w_up, DFF2, kb * 64, (wi >> 7) * DFF + pn * 128 + (wi & 127), (bf16_t*)(p.ws + WS_WUP), D, n0, scr, lane); }
        else { const int r = it - I_UP; wtrans_item(w_dn, D, (r >> 5) * 64, (r & 31) * 32, (bf16_t*)(p.ws + WS_WD), DFF, (r & 31) * 32, scr, lane); }
    }
    ln_rows<true>(p, lds);
}


template <int MODE, int KK>
DI void small_gemm(const Params& p, LAS unsigned char* lds, const bf16_t* A, const bf16_t* Bt) {
    const int tid = opaque_tid(), lane = tid & 63, w = __builtin_amdgcn_readfirstlane(tid >> 6), fr = lane & 15, fq = lane >> 4;
    constexpr int KS = KK / 8 / 32;
    LAS f32x4* red = (LAS f32x4*)lds;
    for (int t = blockIdx.x; t < 256; t += gridDim.x) {
        const int row0 = MP + (t >> 4) * 64, col0 = (t & 15) * 64;
        const bf16_t* ap = A + (size_t)(row0 + fr) * KK + w * (KK / 8) + fq * 8;
        const bf16_t* bp = Bt + (size_t)(col0 + fr) * KK + w * (KK / 8) + fq * 8;
        f32x4 acc[4][4];
#pragma unroll
        for (int i = 0; i < 4; ++i)
#pragma unroll
            for (int j = 0; j < 4; ++j) acc[i][j] = (f32x4){0.f, 0.f, 0.f, 0.f};
#pragma unroll
        for (int k0 = 0; k0 < KS; k0 += 4) {
            bf16x8 af[4][4], bf[4][4];
#pragma unroll
            for (int kk = 0; kk < 4; ++kk)
                if (k0 + kk < KS) {
#pragma unroll
                    for (int i = 0; i < 4; ++i) { af[kk][i] = *(const bf16x8*)(ap + (size_t)(i * 16) * KK + (k0 + kk) * 32); bf[kk][i] = *(const bf16x8*)(bp + (size_t)(i * 16) * KK + (k0 + kk) * 32); }
                }
            __builtin_amdgcn_sched_barrier(0);
#pragma unroll
            for (int kk = 0; kk < 4; ++kk)
                if (k0 + kk < KS) {
#pragma unroll
                    for (int i = 0; i < 4; ++i)
#pragma unroll
                        for (int j = 0; j < 4; ++j) acc[i][j] = MFMA16(af[kk][i], bf[kk][j], acc[i][j]);
                }
        }
        __syncthreads();
#pragma unroll
        for (int i = 0; i < 4; ++i)
#pragma unroll
            for (int j = 0; j < 4; ++j) red[(w * 16 + i * 4 + j) * 64 + lane] = acc[i][j];
        __syncthreads();
#pragma unroll
        for (int q = 0; q < 2; ++q) {
            const int tl = 2 * w + q, rt = tl >> 2, ct = tl & 3;
            f32x4 sum = red[tl * 64 + lane];
#pragma unroll
            for (int ww = 1; ww < 8; ++ww) sum = sum + red[(ww * 16 + tl) * 64 + lane];
            const int col = col0 + ct * 16 + fr;
#pragma unroll
            for (int j = 0; j < 4; ++j) {
                const int row = row0 + rt * 16 + fq * 4 + j;
                float v = sum[j];
                if (MODE < 2) {
                    const bf16_t* zG = (const bf16_t*)(p.ws + WS_ZG + ZG_GAB); bf16_t* MG = (bf16_t*)(p.ws + WS_MG);
                    v *= __uint_as_float((unsigned)zG[(size_t)row * 2048 + MODE * 1024 + col] << 16);
                    if (MODE == 1) v += __uint_as_float((unsigned)MG[(size_t)row * 1024 + col] << 16);
                    MG[(size_t)row * 1024 + col] = (bf16_t)(cvtpk(v, 0.f) & 0xffffu);
                } else {
                    bf16_t* dst = (bf16_t*)(p.ws + (MODE == 2 ? WS_R1 : WS_R2));
                    const float g = ((const float*)(p.ws + WS_MOD))[(size_t)crow_of(row) * 6144 + (MODE == 2 ? 2048 : 5120) + col];
                    dst[(size_t)row * D + col] = (bf16_t)(cvtpk(v * g, 0.f) & 0xffffu);
                }
            }
        }
        __syncthreads();
    }
}

#define XB_TMO      128
#define XB_XCNT(j)  (256  + 64 * (j))
#define XB_XSUB(j)  (1280 + 64 * (j))
#define XB_XGEN(j)  (2304 + 64 * (j))
#define XB_TOP      3328
#define XB_TOPGEN   3392
#define XCD_BAR_WORDS 3456
#define XB_SPIN_CAP (1u << 18)
DI unsigned xb_ld(unsigned* p)              { return __hip_atomic_load(p, __ATOMIC_RELAXED, __HIP_MEMORY_SCOPE_AGENT); }
DI unsigned xb_add(unsigned* p, unsigned v) { return __hip_atomic_fetch_add(p, v, __ATOMIC_RELAXED, __HIP_MEMORY_SCOPE_AGENT); }
DI unsigned xb_xcc_id() { return (unsigned)__builtin_amdgcn_s_getreg((3 << 11) | 20) & 0xFu; }
#define XB_SPIN(cond, bar) do { unsigned _sp = 0; while (cond) { __builtin_amdgcn_s_sleep(1); \
    if ((++_sp & 255u) == 0u) { if (xb_ld(&(bar)[XB_TMO])) break; if (_sp > XB_SPIN_CAP) { atomicAdd(&(bar)[XB_TMO], 1u); break; } } } } while (0)
struct XcdBarrier { unsigned* bar; unsigned x; volatile LAS unsigned* st; };
DI XcdBarrier xcd_barrier_post(unsigned* bar, volatile LAS unsigned* st) {
    XcdBarrier b; b.bar = bar; b.x = xb_xcc_id(); b.st = st;
    if (threadIdx.x == 0) (void)xb_add(&bar[XB_XCNT(b.x)], 1u);
    return b;
}
DI void xcd_barrier_complete(unsigned* bar, unsigned x, unsigned& nloc, unsigned& nx) {
    const unsigned G = gridDim.x * gridDim.y * gridDim.z;
    unsigned sum, cnt, mine, sp = 0u;
    for (;;) {
        sum = 0u; cnt = 0u; mine = 0u;
#pragma unroll
        for (unsigned j = 0; j < 16; ++j) { const unsigned c = xb_ld(&bar[XB_XCNT(j)]); sum += c; cnt += (c > 0u) ? 1u : 0u; mine = (j == x) ? c : mine; }
        if (sum == G) break;
        __builtin_amdgcn_s_sleep(1);
        if ((++sp & 255u) == 0u) { if (xb_ld(&bar[XB_TMO])) break; if (sp > XB_SPIN_CAP) { atomicAdd(&bar[XB_TMO], 1u); break; } }
    }
    nloc = mine > 0u ? mine : 1u; nx = cnt > 0u ? cnt : 1u;
}
DI void xcd_barrier(const XcdBarrier& b) {
    asm volatile("s_waitcnt vmcnt(0)" ::: "memory");
    __syncthreads();
    if (threadIdx.x == 0) {
        unsigned* bar = b.bar;
        __builtin_amdgcn_s_waitcnt(0);
        unsigned nloc = b.st[0], nx = b.st[1];
        if (nloc == 0u) { xcd_barrier_complete(bar, b.x, nloc, nx); b.st[0] = nloc; b.st[1] = nx; }
        const unsigned old = xb_add(&bar[XB_XSUB(b.x)], 1u);
        const unsigned gen = old / nloc;
        if (old + 1u == (gen + 1u) * nloc) {
            __builtin_amdgcn_fence(__ATOMIC_RELEASE, "agent");
            asm volatile("s_waitcnt vmcnt(0)" ::: "memory");
            const unsigned og = xb_add(&bar[XB_TOP], 1u);
            const unsigned tg = og / nx;
            if (og + 1u == (tg + 1u) * nx) xb_add(&bar[XB_TOPGEN], 1u);
            else XB_SPIN(xb_ld(&bar[XB_TOPGEN]) == tg, bar);
            __builtin_amdgcn_fence(__ATOMIC_ACQUIRE, "agent");
            xb_add(&bar[XB_XGEN(b.x)], 1u);
            asm volatile("s_waitcnt vmcnt(0)" ::: "memory");
        } else {
            XB_SPIN(xb_ld(&bar[XB_XGEN(b.x)]) == gen, bar);
            __builtin_amdgcn_fence(__ATOMIC_ACQUIRE, "agent");
            asm volatile("s_waitcnt vmcnt(0)" ::: "memory");
        }
    }
    __syncthreads();
}
constexpr int LDS_XBST = 146688;
constexpr size_t WS_BAR = WS_END;
static_assert(WS_BAR + XCD_BAR_WORDS * 4 <= 536870912, "ws bar");

template <int LO, int HI>
__global__ void __launch_bounds__(512) mk_fwd(Params p) {
    extern __shared__ __attribute__((aligned(16))) unsigned char smem[];
    LAS unsigned char* lds = (LAS unsigned char*)smem;
    cg::grid_group grid = cg::this_grid();
    {
#pragma unroll
        for (int i = 0; i < 29; ++i) if (threadIdx.x == i) *(LAS unsigned long long*)(lds + LDS_TAB + 8 * i) = (unsigned long long)p.in[i];
    }
    if (threadIdx.x < 2) ((volatile LAS unsigned*)(lds + LDS_XBST))[threadIdx.x] = 0u;
    __syncthreads();
    constexpr int lo = LO, hi = HI;
    if (p.ph_lo < 0) grid.sync();
    XcdBarrier xbar; xbar.bar = (unsigned*)(p.ws + WS_BAR); xbar.x = 0; xbar.st = (volatile LAS unsigned*)(lds + LDS_XBST);
    if (HI - LO > 1) xbar = xcd_barrier_post((unsigned*)(p.ws + WS_BAR), (volatile LAS unsigned*)(lds + LDS_XBST));
#ifndef PROBE_MASK
#define PROBE_MASK 0
#endif
#define REPS(k) (1 + ((PROBE_MASK >> (k)) & 1))
#define IN(k) (lo <= (k) && (k) < hi)
#define SEAM(k) do { if (IN(k) && IN((k) + 1)) xcd_barrier(xbar); } while (0)
    if (IN(0)) { phase0a(p, lds);
    }
    SEAM(0);
    if (IN(1)) { phase0b(p, lds);
    }
    SEAM(1);
    if (IN(2)) {
        mscan(p, lds);
        EpiWin E{p.ws, p.out};
        pg8::gemm_phase<EpiWin, true, 132, 25, 0, D>(lds, (const bf16_t*)((unsigned char*)p.out + OY_H1), (const bf16_t*)(p.ws + WS_WIN), E);
    }
    SEAM(2);
    if (IN(3)) { phase2(p, lds);
    }
    SEAM(3);
    if (IN(4)) phase3(p, lds);
    SEAM(4);
    if (IN(5)) { phase4(p, lds);
    }
    SEAM(5);
    if (IN(6)) {
        { EpiProj<0> E{p.ws}; pg8::gemm_phase<EpiProj<0>, true, 128, 4, 0, D>(lds, (const bf16_t*)((unsigned char*)p.out + OY_YA), (const bf16_t*)(p.ws + WS_WPA), E); }
        small_gemm<0, D>(p, lds, (const bf16_t*)((unsigned char*)p.out + OY_YA), (const bf16_t*)(p.ws + WS_WPA));
        { EpiProj<1> E{p.ws}; pg8::gemm_phase<EpiProj<1>, true, 128, 4, 0, D>(lds, (const bf16_t*)((unsigned char*)p.out + OY_YB), (const bf16_t*)(p.ws + WS_WPB), E); }
        small_gemm<1, D>(p, lds, (const bf16_t*)((unsigned char*)p.out + OY_YB), (const bf16_t*)(p.ws + WS_WPB));
    }
    SEAM(6);
    if (IN(7)) { EpiRes<0> E{p.ws, p.out, lds}; pg8::gemm_phase<EpiRes<0>, true, 128, 4, 0, D>(lds, (const bf16_t*)(p.ws + WS_MG), (const bf16_t*)(p.ws + WS_WO), E);
        small_gemm<2, D>(p, lds, (const bf16_t*)(p.ws + WS_MG), (const bf16_t*)(p.ws + WS_WO)); }
    SEAM(7);
    if (IN(8)) phase7(p, lds);
    SEAM(8);
    if (IN(9)) { EpiUp E{p.ws, p.out, lds}; pg8::gemm_phase<EpiUp, true, 136, 22, 1, D, true>(lds, (const bf16_t*)((unsigned char*)p.out + OY_H2), (const bf16_t*)(p.ws + WS_WUP), E); }
    SEAM(9);
    if (IN(10)) { EpiRes<1> E{p.ws, p.out, lds}; pg8::gemm_phase<EpiRes<1>, true, 128, 4, 0, DFF>(lds, (const bf16_t*)(p.ws + WS_ACT), (const bf16_t*)(p.ws + WS_WD), E);
        small_gemm<3, DFF>(p, lds, (const bf16_t*)(p.ws + WS_ACT), (const bf16_t*)(p.ws + WS_WD)); }
    SEAM(10);
    if (IN(11)) ln_rows<false>(p, lds);
}

template <int K> static void launch_one(Params& p, int grid, hipStream_t stream) {
    hipFuncSetAttribute((const void*)mk_fwd<K, K + 1>, hipFuncAttributeMaxDynamicSharedMemorySize, LDS_BYTES);
    const int reps = 1 + ((PROBE_MASK >> K) & 1);
    for (int r = 0; r < reps; ++r) hipLaunchKernelGGL((mk_fwd<K, K + 1>), dim3(grid), dim3(512), LDS_BYTES, stream, p);
}
extern "C" void kernel_launch(void* const* d_in, const int* in_sizes, int n_in, void* d_out, int out_size, void* d_ws, size_t ws_size, hipStream_t stream) {
    static int grid_blocks = 0;
    if (!grid_blocks) {
        int dev = 0, cus = 0, per_cu = 0;
        (void)hipGetDevice(&dev);
        (void)hipDeviceGetAttribute(&cus, hipDeviceAttributeMultiprocessorCount, dev);
        (void)hipFuncSetAttribute((const void*)mk_fwd<0, NPH>, hipFuncAttributeMaxDynamicSharedMemorySize, LDS_BYTES);
        (void)hipOccupancyMaxActiveBlocksPerMultiprocessor(&per_cu, mk_fwd<0, NPH>, 512, LDS_BYTES);
        if (per_cu < 1) per_cu = 1;
        grid_blocks = cus * per_cu;
    }
    Params p{};
    for (int i = 0; i < 29; ++i) p.in[i] = (const float*)d_in[i];
    p.out = (float*)d_out; p.ws = (unsigned char*)d_ws; p.ph_lo = 0; p.ph_hi = NPH;
#ifdef PROBE_MULTI
    launch_one<0>(p, grid_blocks, stream); launch_one<1>(p, grid_blocks, stream); launch_one<2>(p, grid_blocks, stream); launch_one<3>(p, grid_blocks, stream);
    launch_one<4>(p, grid_blocks, stream); launch_one<5>(p, grid_blocks, stream); launch_one<6>(p, grid_blocks, stream); launch_one<7>(p, grid_blocks, stream);
    launch_one<8>(p, grid_blocks, stream); launch_one<9>(p, grid_blocks, stream); launch_one<10>(p, grid_blocks, stream); launch_one<11>(p, grid_blocks, stream);
#else
    (void)hipMemsetAsync((unsigned char*)d_ws + WS_BAR, 0, XCD_BAR_WORDS * 4, stream);
    void* args[] = {&p};
    hipError_t e = hipLaunchCooperativeKernel((const void*)mk_fwd<0, NPH>, dim3(grid_blocks), dim3(512), args, LDS_BYTES, stream);
    if (e != hipSuccess) fprintf(stderr, "cooperative launch failed: %s (grid %d)\n", hipGetErrorString(e), grid_blocks);
#endif
}
```
